# Optimizing an MI355X kernel written in HIP

```python
import math
import jax
import jax.numpy as jnp
from jax import lax
import numpy as np

D_MODEL = 1024
BATCH = 2
SEQ = 8192
DEPTH = 4
DEC_BATCH = 32
DEC_SEQ = 64
PAST_LEN = 2048

CHUNK = 64
HEAD_DIM = 64
D_MIX = D_MODEL
RMS_EPS = 1e-6
NEG_INF = -1e30
N_EVEN = (DEPTH + 1) // 2
N_ODD = DEPTH // 2

H_A = (D_MIX // 2) // HEAD_DIM
KVH_A = 2
G_A = H_A // KVH_A
WINDOW = 128
A_LEFT = WINDOW // CHUNK
A_KEEP = min(WINDOW, PAST_LEN)
T5_BUCKETS = 32
T5_MAX_DIST = 128

C_B = D_MIX // 2
H_B = C_B // HEAD_DIM
DECAY_LORA = 64
ICLR_LORA = 64
VRES_LORA = 32
GATE_LORA = 128
LNX_EPS = 64e-5
B_SPLITS = (C_B, DECAY_LORA, C_B, C_B, ICLR_LORA, GATE_LORA)
B_PROJ = sum(B_SPLITS)

H_C = (D_MIX // 2) // HEAD_DIM
C_LEFT = 8
C_KEEP = min(C_LEFT * CHUNK, PAST_LEN)
REL_CLIP = 128

C_D = D_MIX // 2
CONV_W = 31
LN_EPS = 1e-5

D_FF = -(-8 * D_MODEL // (3 * 256)) * 256

E_SPLITS = (H_A * HEAD_DIM, KVH_A * HEAD_DIM, KVH_A * HEAD_DIM, B_PROJ)
O_SPLITS = (H_C * HEAD_DIM, H_C * HEAD_DIM, H_C * HEAD_DIM, 2 * C_D)
E_IN = sum(E_SPLITS)
O_IN = sum(O_SPLITS)

kernel_name = 'hybrid_streaming_encoder_step'


def split_cols(p, sizes):
    return jnp.split(p, np.cumsum(sizes)[:-1].tolist(), axis=-1)


def rmsnorm(x, g):
    xf = x.astype(jnp.float32)
    y = xf * lax.rsqrt(jnp.mean(xf * xf, axis=-1, keepdims=True) + RMS_EPS)
    return (y * g.astype(jnp.float32)).astype(x.dtype)


def t5_bucket(rel):
    nb = T5_BUCKETS // 2
    exact = nb // 2
    n = np.abs(rel)
    nf = np.maximum(n, exact).astype(np.float32)
    large = exact + (np.log(nf / exact) / math.log(T5_MAX_DIST / exact) * (nb - exact)).astype(np.int32)
    return np.where(rel > 0, nb, 0) + np.where(n < exact, n, np.minimum(large, nb - 1))


def t5_bias(table, rel):
    b = table[jnp.asarray(t5_bucket(rel))]
    return jnp.moveaxis(b, -1, 0).reshape((KVH_A, G_A) + rel.shape).astype(jnp.float32)


def clipped_rel_bias(table, dist):
    idx = np.clip(dist, -REL_CLIP, REL_CLIP) + REL_CLIP
    return table[:, jnp.asarray(idx)][:, None].astype(jnp.float32)


def chunk_band(t, n_left):
    b, s = t.shape[:2]
    nc = s // CHUNK
    tp = jnp.pad(t, ((0, 0), (n_left * CHUNK, 0)) + ((0, 0),) * (t.ndim - 2))
    tc = tp.reshape((b, nc + n_left, CHUNK) + t.shape[2:])
    return jnp.concatenate([tc[:, o:o + nc] for o in range(n_left + 1)], axis=2)


def prompt_band_geometry(n_left, seq):
    nk = (n_left + 1) * CHUNK
    rel = np.arange(nk)[None, :] - n_left * CHUNK - np.arange(CHUNK)[:, None]
    kpos = (np.arange(seq // CHUNK)[:, None] - n_left) * CHUNK + np.arange(nk)[None, :]
    return rel, jnp.asarray(kpos >= 0)[:, None, None, None, :]


def sample_rel(keep, t):
    qpos = PAST_LEN + np.arange(t)
    kpos = np.concatenate([PAST_LEN - keep + np.arange(keep), PAST_LEN + np.arange(t)])
    return kpos[None, :] - qpos[:, None]


def attend(q, k, v, bias, mask, sink):
    s = jnp.einsum('...qhgd,...khd->...hgqk', q, k).astype(jnp.float32) * (HEAD_DIM ** -0.5) + bias
    if mask is not None:
        s = jnp.where(mask, s, NEG_INF)
    if sink is None:
        p = jax.nn.softmax(s, axis=-1)
    else:
        sk = sink.astype(jnp.float32)[..., None, None]
        m = jnp.maximum(jnp.max(s, axis=-1, keepdims=True), sk)
        e = jnp.exp(s - m)
        p = e / (jnp.sum(e, axis=-1, keepdims=True) + jnp.exp(sk - m))
    return jnp.einsum('...hgqk,...khd->...qhgd', p.astype(v.dtype), v)


def mixer_a(q, k, v, sink, t5_table, cache):
    b, t = q.shape[:2]
    q = q.reshape(b, t, KVH_A, G_A, HEAD_DIM)
    sk = sink.reshape(KVH_A, G_A)
    if cache is None:
        rel, valid = prompt_band_geometry(A_LEFT, t)
        qc = q.reshape(b, t // CHUNK, CHUNK, KVH_A, G_A, HEAD_DIM)
        o = attend(qc, chunk_band(k, A_LEFT), chunk_band(v, A_LEFT), t5_bias(t5_table, rel), valid, sk)
        new = (k[:, -WINDOW:], v[:, -WINDOW:])
    else:
        ck, cv = cache
        rel = sample_rel(ck.shape[1], t)
        kk = jnp.concatenate([ck.astype(k.dtype), k], axis=1)
        vv = jnp.concatenate([cv.astype(v.dtype), v], axis=1)
        o = attend(q, kk, vv, t5_bias(t5_table, rel), None, sk)
        new = (k, v)
    return o.reshape(b, t, H_A * HEAD_DIM), new


def mixer_c(q, k, v, rel_table, cache):
    b, t = q.shape[:2]
    q = q[:, :, :, None, :]
    if cache is None:
        rel, valid = prompt_band_geometry(C_LEFT, t)
        qc = q.reshape(b, t // CHUNK, CHUNK, H_C, 1, HEAD_DIM)
        o = attend(qc, chunk_band(k, C_LEFT), chunk_band(v, C_LEFT), clipped_rel_bias(rel_table, -rel), valid, None)
        new = (k[:, -C_LEFT * CHUNK:], v[:, -C_LEFT * CHUNK:])
    else:
        ck, cv = cache
        rel = sample_rel(ck.shape[1], t)
        kk = jnp.concatenate([ck.astype(k.dtype), k], axis=1)
        vv = jnp.concatenate([cv.astype(v.dtype), v], axis=1)
        o = attend(q, kk, vv, clipped_rel_bias(rel_table, -rel), None, None)
        new = (k, v)
    return o.reshape(b, t, H_C * HEAD_DIM), new


def rwkv7_scan(r, decay, k, v, a, bb, s0):
    def step(s, inp):
        r_t, w_t, k_t, v_t, a_t, b_t = inp
        sa = jnp.einsum('bhij,bhj->bhi', s, a_t)
        s = s * w_t[:, :, None, :] + sa[..., None] * b_t[:, :, None, :] + v_t[..., None] * k_t[:, :, None, :]
        return s, jnp.einsum('bhij,bhj->bhi', s, r_t)
    xs = tuple(jnp.moveaxis(z, 1, 0) for z in (r, decay, k, v, a, bb))
    s, ys = lax.scan(step, s0, xs)
    return jnp.moveaxis(ys, 0, 1), s


def mixer_b(pb, shift_prev, wkv0, v_first, mu, w0, w2, a0, a2, g2, kk_scale, k_a, r_k, lnx_w, lnx_b, vres):
    b, t, _ = pb.shape
    f32 = jnp.float32
    prev = jnp.concatenate([shift_prev[:, None].astype(pb.dtype), pb[:, :-1]], axis=1)
    xsh = pb + (prev - pb) * mu
    r, wd, k, v, ad, gd = split_cols(xsh, B_SPLITS)
    w = -jax.nn.softplus(-(w0 + jnp.tanh(wd) @ w2)) - 0.5
    a = jax.nn.sigmoid(a0 + ad @ a2)
    g = jax.nn.sigmoid(gd) @ g2
    if vres is None:
        v_first = v
    else:
        v0, v1, v2 = vres
        v = v + (v_first - v) * jax.nn.sigmoid(v0 + (v @ v1) @ v2)
    heads = lambda z: z.reshape(b, t, H_B, HEAD_DIM).astype(f32)
    kk = heads(k * kk_scale)
    kk = kk / jnp.maximum(jnp.sqrt(jnp.sum(kk * kk, axis=-1, keepdims=True)), 1e-12)
    kh = heads(k * (1 + (a - 1) * k_a))
    rh, vh, ah = heads(r), heads(v), heads(a)
    decay = jnp.exp(-jnp.exp(heads(w)))
    y, wkv = rwkv7_scan(rh, decay, kh, vh, -kk, kk * ah, wkv0.astype(f32))
    mean = jnp.mean(y, axis=-1, keepdims=True)
    var = jnp.mean(jnp.square(y - mean), axis=-1, keepdims=True)
    y = (y - mean) * lax.rsqrt(var + LNX_EPS) * lnx_w.reshape(H_B, HEAD_DIM).astype(f32) + lnx_b.reshape(H_B, HEAD_DIM).astype(f32)
    y = y + jnp.sum(rh * kh * r_k.astype(f32), axis=-1, keepdims=True) * vh
    out = y.reshape(b, t, C_B).astype(pb.dtype) * g
    return out, v_first, pb[:, -1], wkv


def mixer_d(pd, conv_prev, dw_w, dw_b, ln_g, ln_b):
    u = pd[..., :C_D] * jax.nn.sigmoid(pd[..., C_D:])
    b = u.shape[0]
    buf = jnp.zeros((b, CONV_W - 1, C_D), u.dtype) if conv_prev is None else conv_prev.astype(u.dtype)
    up = jnp.concatenate([buf, u], axis=1)
    z = lax.conv_general_dilated(up, dw_w[:, None, :].astype(u.dtype), window_strides=(1,), padding='VALID',
                                 dimension_numbers=('NWC', 'WIO', 'NWC'), feature_group_count=C_D) + dw_b
    zf = z.astype(jnp.float32)
    mean = jnp.mean(zf, axis=-1, keepdims=True)
    var = jnp.mean(jnp.square(zf - mean), axis=-1, keepdims=True)
    zn = (zf - mean) * lax.rsqrt(var + LN_EPS) * ln_g.astype(jnp.float32) + ln_b.astype(jnp.float32)
    return jax.nn.silu(zn).astype(u.dtype), up[:, -(CONV_W - 1):]


def swiglu(h, wg, wu, wd):
    return (jax.nn.silu(h @ wg) * (h @ wu)) @ wd


def setup_inputs(seed: int = 0) -> dict:
    key = jax.random.key(seed)
    keys = iter(jax.random.split(key, 48))

    def nrm(shape, scale=1.0, mean=0.0):
        return mean + scale * jax.random.normal(next(keys), shape, jnp.float32)

    def uni(shape, lo, hi):
        return jax.random.uniform(next(keys), shape, jnp.float32, lo, hi)

    NE, NO = N_EVEN, N_ODD
    return {
        'x_prompt': nrm((BATCH, SEQ, D_MODEL)),
        'x_sample': nrm((DEC_BATCH, DEC_SEQ, D_MODEL)),
        'cache_a_k': nrm((NE, DEC_BATCH, A_KEEP, KVH_A, HEAD_DIM)),
        'cache_a_v': nrm((NE, DEC_BATCH, A_KEEP, KVH_A, HEAD_DIM)),
        'state_b_wkv': nrm((NE, DEC_BATCH, H_B, HEAD_DIM, HEAD_DIM), 0.5),
        'state_b_shift': nrm((NE, DEC_BATCH, B_PROJ)),
        'cache_c_k': nrm((NO, DEC_BATCH, C_KEEP, H_C, HEAD_DIM)),
        'cache_c_v': nrm((NO, DEC_BATCH, C_KEEP, H_C, HEAD_DIM)),
        'state_d_conv': nrm((NO, DEC_BATCH, CONV_W - 1, C_D), 0.5),
        'norm_mix_g': nrm((DEPTH, D_MODEL), 0.05, 1.0),
        'norm_ffn_g': nrm((DEPTH, D_MODEL), 0.05, 1.0),
        'norm_final_g': nrm((D_MODEL,), 0.05, 1.0),
        't5_table': nrm((T5_BUCKETS, H_A), 0.5),
        'w_in_e': nrm((NE, D_MODEL, E_IN), D_MODEL ** -0.5),
        'w_out_e': nrm((NE, D_MIX, D_MODEL), D_MIX ** -0.5),
        'a_sink': nrm((NE, H_A), 0.5),
        'b_mu': uni((NE, B_PROJ), 0.0, 1.0),
        'b_w0': uni((NE, C_B), -6.0, -1.0),
        'b_w2': nrm((NE, DECAY_LORA, C_B), 0.1 * DECAY_LORA ** -0.5),
        'b_a0': nrm((NE, C_B), 0.1),
        'b_a2': nrm((NE, ICLR_LORA, C_B), ICLR_LORA ** -0.5),
        'b_g2': nrm((NE, GATE_LORA, C_B), GATE_LORA ** -0.5),
        'b_kk': nrm((NE, C_B), 0.05, 0.85),
        'b_ka': nrm((NE, C_B), 0.05, 1.0),
        'b_rk': nrm((NE, H_B, HEAD_DIM), 0.1),
        'b_lnx_w': nrm((NE, C_B), 0.05, 1.0),
        'b_lnx_b': nrm((NE, C_B), 0.02),
        'b_v0': nrm((NE - 1, C_B), 0.1),
        'b_v1': nrm((NE - 1, C_B, VRES_LORA), C_B ** -0.5),
        'b_v2': nrm((NE - 1, VRES_LORA, C_B), VRES_LORA ** -0.5),
        'w_in_o': nrm((NO, D_MODEL, O_IN), D_MODEL ** -0.5),
        'w_out_o': nrm((NO, D_MIX, D_MODEL), D_MIX ** -0.5),
        'c_rel_table': nrm((NO, H_C, 2 * REL_CLIP + 1), 0.5),
        'd_dw_w': nrm((NO, CONV_W, C_D), CONV_W ** -0.5),
        'd_dw_b': nrm((NO, C_D), 0.02),
        'd_ln_g': nrm((NO, C_D), 0.05, 1.0),
        'd_ln_b': nrm((NO, C_D), 0.02),
        'ffn_w_gate': nrm((DEPTH, D_MODEL, D_FF), D_MODEL ** -0.5),
        'ffn_w_up': nrm((DEPTH, D_MODEL, D_FF), D_MODEL ** -0.5),
        'ffn_w_down': nrm((DEPTH, D_FF, D_MODEL), D_FF ** -0.5),
    }


def reference(x_prompt, x_sample, cache_a_k, cache_a_v, state_b_wkv, state_b_shift,
              cache_c_k, cache_c_v, state_d_conv,
              norm_mix_g, norm_ffn_g, norm_final_g, t5_table,
              w_in_e, w_out_e, a_sink,
              b_mu, b_w0, b_w2, b_a0, b_a2, b_g2, b_kk, b_ka, b_rk, b_lnx_w, b_lnx_b,
              b_v0, b_v1, b_v2,
              w_in_o, w_out_o, c_rel_table, d_dw_w, d_dw_b, d_ln_g, d_ln_b,
              ffn_w_gate, ffn_w_up, ffn_w_down):
    xs = [x_prompt, x_sample]
    v_first = [None, None]
    st = [[[] for _ in range(7)] for _ in range(2)]
    for i in range(DEPTH):
        j = i // 2
        for gi in range(2):
            x = xs[gi]
            b, t = x.shape[:2]
            h = rmsnorm(x, norm_mix_g[i])
            if i % 2 == 0:
                q, k, v, pb = split_cols(h @ w_in_e[j], E_SPLITS)
                cache = None if gi == 0 else (cache_a_k[j], cache_a_v[j])
                oa, (nk, nv) = mixer_a(q.reshape(b, t, H_A, HEAD_DIM), k.reshape(b, t, KVH_A, HEAD_DIM),
                                       v.reshape(b, t, KVH_A, HEAD_DIM), a_sink[j], t5_table, cache)
                if gi == 0:
                    shift0 = jnp.zeros((b, B_PROJ), x.dtype)
                    wkv0 = jnp.zeros((b, H_B, HEAD_DIM, HEAD_DIM), jnp.float32)
                else:
                    shift0, wkv0 = state_b_shift[j], state_b_wkv[j]
                vres = None if j == 0 else (b_v0[j - 1], b_v1[j - 1], b_v2[j - 1])
                ob, v_first[gi], nshift, nwkv = mixer_b(pb, shift0, wkv0, v_first[gi], b_mu[j], b_w0[j], b_w2[j],
                                                        b_a0[j], b_a2[j], b_g2[j], b_kk[j], b_ka[j], b_rk[j],
                                                        b_lnx_w[j], b_lnx_b[j], vres)
                x = x + jnp.concatenate([oa, ob], axis=-1) @ w_out_e[j]
                for s_list, val in zip(st[gi][0:4], (nk, nv, nwkv, nshift)):
                    s_list.append(val)
            else:
                q, k, v, pd = split_cols(h @ w_in_o[j], O_SPLITS)
                cache = None if gi == 0 else (cache_c_k[j], cache_c_v[j])
                oc, (nk, nv) = mixer_c(q.reshape(b, t, H_C, HEAD_DIM), k.reshape(b, t, H_C, HEAD_DIM),
                                       v.reshape(b, t, H_C, HEAD_DIM), c_rel_table[j], cache)
                conv_prev = None if gi == 0 else state_d_conv[j]
                od, nconv = mixer_d(pd, conv_prev, d_dw_w[j], d_dw_b[j], d_ln_g[j], d_ln_b[j])
                x = x + jnp.concatenate([oc, od], axis=-1) @ w_out_o[j]
                for s_list, val in zip(st[gi][4:7], (nk, nv, nconv)):
                    s_list.append(val)
            h = rmsnorm(x, norm_ffn_g[i])
            xs[gi] = x + swiglu(h, ffn_w_gate[i], ffn_w_up[i], ffn_w_down[i])
    y_prompt = rmsnorm(xs[0], norm_final_g)
    y_sample = rmsnorm(xs[1], norm_final_g)
    (pak, pav, pbw, pbs, pck, pcv, pdc), (sak, sav, sbw, sbs, sck, scv, sdc) = [[jnp.stack(s) for s in g] for g in st]
    return (y_prompt, y_sample, pak, pav, pbw, pbs, pck, pcv, pdc, sak, sav, sbw, sbs, sck, scv, sdc)
```

```cpp
#include <hip/hip_runtime.h>
#include <cstdio>
#include <cstdint>
namespace pg8 {
#define PG8_LAS __attribute__((address_space(3)))
typedef unsigned short bf16_t;
typedef short bf16x8 __attribute__((ext_vector_type(8)));
typedef float f32x4 __attribute__((ext_vector_type(4)));
typedef unsigned u32x4 __attribute__((ext_vector_type(4)));
constexpr int BM = 256, BK = 64, HALF = 128, HTB = HALF * BK * 2  , STAGE_BYTES = 8 * HTB, NXCD = 8, WGM = 8;

__host__ __device__ __forceinline__ int lds_byte(int r, int c) { const int st = (r >> 4) * 2 + (c >> 5), rr = r & 15, cc = c & 31, ob = rr * 64 + cc * 2; return st * 1024 + (ob ^ (((ob >> 9) & 1) << 5)); }
__host__ __device__ __forceinline__ void stage_rc(int b, int& R, int& C) { const int st = b / 1024, sb = b % 1024, swz = sb ^ (((sb >> 9) & 1) << 5); R = (st >> 1) * 16 + swz / 64; C = (st & 1) * 32 + (swz % 64) / 2; }
__host__ __device__ __forceinline__ int perm32(int rho) { const int n = rho >> 4, i = rho & 15; return 8 * (i >> 2) + 4 * n + (i & 3); }

struct Unit { int pm, pn; };
struct Gemm { const bf16_t* A; const bf16_t* Bt; int M, N, K; };

struct StaticOrder {
    int nM, nN, nwg, G, c;
    __host__ __device__ void init(int M, int N, int G_, int c_) { nM = M / BM; nN = N / BM; nwg = nM * nN; G = G_; c = c_; }
    __host__ __device__ bool next(int i, Unit& u) const {
        const long L = (long)i * G + c; if (L >= nwg) return false;
        int wgid = (int)L; { const int q = nwg / NXCD, r = nwg % NXCD, xcd = wgid % NXCD, off = wgid / NXCD; wgid = (xcd < r ? xcd * (q + 1) : r * (q + 1) + (xcd - r) * q) + off; }
        const int nig = WGM * nN, gid = wgid / nig, fm = gid * WGM, gsz = (nM - fm) < WGM ? (nM - fm) : WGM;
        u.pm = fm + ((wgid % nig) % gsz); u.pn = (wgid % nig) / gsz; return true;
    }
    __device__ __forceinline__ void a_ready(const Unit&) const {}
    __device__ __forceinline__ void done(const Unit&) const {}
};

typedef float f32x2_t __attribute__((ext_vector_type(2))); typedef __bf16 bf16x2_t __attribute__((ext_vector_type(2)));
__device__ __forceinline__ unsigned cvt_pk_bf16(float lo, float hi) { f32x2_t v = {lo, hi}; bf16x2_t b = __builtin_convertvector(v, bf16x2_t); return __builtin_bit_cast(unsigned, b); }

template <class Epi, class Sched, bool ALIGN_EPI = false, bool SP2 = false>
__device__ __forceinline__ void gemm_phase(PG8_LAS unsigned char* lds, const Gemm g, const Sched& S, const Epi& E) {
    int tid_ = threadIdx.x; asm volatile("" : "+v"(tid_));
    const int tid = tid_, wid = __builtin_amdgcn_readfirstlane(tid >> 6), lane = tid & 63, wr = wid >> 2, wc = wid & 3, fr = lane & 15, fq = lane >> 4;
    const int K = g.K, nt = K / BK;
    unsigned voffA[2], voffB[2];
#pragma unroll
    for (int i = 0; i < 2; ++i) { int R, C; stage_rc(tid * 16 + i * 8192, R, C); const int Rb = Epi::PERM ? ((R & ~31) + perm32(R & 31)) : R;
        voffA[i] = (unsigned)(R * K + C) * 2u; voffB[i] = (unsigned)(Rb * K + C) * 2u; }
    const size_t kstep = (size_t)(BK * 2);
    const size_t hstep = (size_t)HALF * K * 2;
    const size_t tstep = 2 * hstep;
    const unsigned ldsw = (unsigned)wid * 1024u;
    const int aoff = lds_byte(wr * 64 + fr, fq * 8), boff = lds_byte(wc * 32 + fr, fq * 8);
#define PG8_SA(b, h) (((b) * 2 + (h)) * HTB)
#define PG8_SB(b, h) ((4 + (b) * 2 + (h)) * HTB)
#define PG8_STAGE(bufoff, gbase, voff) do { _Pragma("unroll") for (int _i = 0; _i < 2; ++_i) \
        __builtin_amdgcn_global_load_lds((const unsigned*)((const char*)(gbase) + (voff)[_i]), (PG8_LAS unsigned*)(lds + (bufoff) + ldsw + _i * 8192), 16, 0, 0); } while (0)
#define PG8_LDA(dst, b, h) do { _Pragma("unroll") for (int m = 0; m < 4; ++m) _Pragma("unroll") for (int k = 0; k < 2; ++k) dst[m][k] = *(const PG8_LAS bf16x8*)(lds + PG8_SA(b, h) + aoff + m * 2048 + k * 1024); } while (0)
#define PG8_LDB(dst, b, h) do { _Pragma("unroll") for (int n = 0; n < 2; ++n) _Pragma("unroll") for (int k = 0; k < 2; ++k) dst[n][k] = *(const PG8_LAS bf16x8*)(lds + PG8_SB(b, h) + boff + n * 2048 + k * 1024); } while (0)
#define PG8_MMA(ai, bj, At, Bt) do { __builtin_amdgcn_s_setprio(1); _Pragma("unroll") for (int m = 0; m < 4; ++m) _Pragma("unroll") for (int n = 0; n < 2; ++n) _Pragma("unroll") for (int k = 0; k < 2; ++k) \
        acc[ai][bj][m][n] = __builtin_amdgcn_mfma_f32_16x16x32_bf16(Bt[n][k], At[m][k], acc[ai][bj][m][n], 0, 0, 0); __builtin_amdgcn_s_setprio(0); } while (0)
#define PG8_WAIT_V(n) asm volatile("s_waitcnt vmcnt(" #n ")" ::: "memory")
#define PG8_WAIT_L(n) asm volatile("s_waitcnt lgkmcnt(" #n ")" ::: "memory")
#define PG8_BAR __builtin_amdgcn_s_barrier()
#define PG8_SCHED __builtin_amdgcn_sched_barrier(0)
    Unit cur, nxt; int ui = 0;
    if (!S.next(0, cur)) return;
    f32x4 acc[2][2][4][2];
#pragma unroll
    for (int a = 0; a < 2; ++a)
#pragma unroll
        for (int b = 0; b < 2; ++b)
#pragma unroll
            for (int m = 0; m < 4; ++m)
#pragma unroll
                for (int n = 0; n < 2; ++n) acc[a][b][m][n] = (f32x4){0.f, 0.f, 0.f, 0.f};
    bf16x8 At[4][2], B0[2][2], B1[2][2];
    const char* cA = (const char*)g.A + (size_t)cur.pm * tstep; const char* cB = (const char*)g.Bt + (size_t)cur.pn * tstep;
    S.a_ready(cur);
    if constexpr (SP2) {
        PG8_STAGE(PG8_SB(0, 0), cB, voffB); PG8_STAGE(PG8_SB(0, 1), cB + hstep, voffB); PG8_STAGE(PG8_SA(0, 0), cA, voffA); PG8_STAGE(PG8_SA(0, 1), cA + hstep, voffA);
        if (wr == 1) PG8_BAR;
        PG8_WAIT_V(2); PG8_BAR;
        PG8_STAGE(PG8_SB(1, 0), cB + kstep, voffB); PG8_STAGE(PG8_SA(1, 0), cA + kstep, voffA); PG8_STAGE(PG8_SB(1, 1), cB + hstep + kstep, voffB);
        PG8_WAIT_V(6); PG8_BAR;
    } else {
        PG8_STAGE(PG8_SB(0, 0), cB, voffB); PG8_STAGE(PG8_SA(0, 0), cA, voffA); PG8_STAGE(PG8_SB(0, 1), cB + hstep, voffB); PG8_STAGE(PG8_SA(0, 1), cA + hstep, voffA);
        if (wr == 1) PG8_BAR;
        PG8_WAIT_V(4); PG8_BAR;
        PG8_STAGE(PG8_SB(1, 0), cB + kstep, voffB); PG8_STAGE(PG8_SA(1, 0), cA + kstep, voffA); PG8_STAGE(PG8_SB(1, 1), cB + hstep + kstep, voffB);
        PG8_WAIT_V(6); PG8_BAR;
    }
    for (;;) {
        const bool has_next = S.next(ui + 1, nxt);
        const char* nA = has_next ? (const char*)g.A + (size_t)nxt.pm * tstep : cA; const char* nB = has_next ? (const char*)g.Bt + (size_t)nxt.pn * tstep : cB;
        for (int t = 0; t < nt; t += 2) {
            const bool last = (t == nt - 2);
            const char* a1 = cA + (size_t)(t + 1) * kstep;
            const char* a2 = last ? nA : cA + (size_t)(t + 2) * kstep; const char* b2 = last ? nB : cB + (size_t)(t + 2) * kstep;
            const char* a3 = a2 + kstep; const char* b3 = b2 + kstep;
            if (last && has_next) S.a_ready(nxt);
            if constexpr (SP2) {
            PG8_LDB(B0, 0, 0); PG8_LDB(B1, 0, 1); PG8_SCHED; PG8_LDA(At, 0, 0); PG8_STAGE(PG8_SA(1, 1), a1 + hstep, voffA);
            PG8_WAIT_V(8); PG8_WAIT_L(0); PG8_BAR; PG8_MMA(0, 0, At, B0); PG8_MMA(0, 1, At, B1); PG8_BAR; PG8_SCHED;
            PG8_LDA(At, 0, 1); PG8_STAGE(PG8_SB(0, 0), b2, voffB); PG8_STAGE(PG8_SB(0, 1), b2 + hstep, voffB); PG8_STAGE(PG8_SA(0, 0), a2, voffA);
            PG8_WAIT_V(8); PG8_WAIT_L(0); PG8_BAR; PG8_MMA(1, 0, At, B0); PG8_MMA(1, 1, At, B1); PG8_BAR; PG8_SCHED;
            PG8_LDB(B0, 1, 0); PG8_LDB(B1, 1, 1); PG8_SCHED; PG8_LDA(At, 1, 0); PG8_STAGE(PG8_SA(0, 1), a2 + hstep, voffA);
            PG8_WAIT_V(8); PG8_WAIT_L(0); PG8_BAR; PG8_MMA(0, 0, At, B0); PG8_MMA(0, 1, At, B1); PG8_BAR; PG8_SCHED;
            PG8_LDA(At, 1, 1); PG8_STAGE(PG8_SB(1, 0), b3, voffB); PG8_STAGE(PG8_SB(1, 1), b3 + hstep, voffB); PG8_STAGE(PG8_SA(1, 0), a3, voffA);
            PG8_WAIT_V(8); PG8_WAIT_L(0); PG8_BAR; PG8_MMA(1, 0, At, B0); PG8_MMA(1, 1, At, B1); PG8_BAR; PG8_SCHED;
            } else {
            PG8_LDB(B0, 0, 0); PG8_SCHED; PG8_LDA(At, 0, 0); PG8_STAGE(PG8_SA(1, 1), a1 + hstep, voffA);
            PG8_WAIT_L(8); PG8_BAR; PG8_WAIT_L(0); PG8_MMA(0, 0, At, B0); PG8_BAR; PG8_SCHED;
            PG8_LDB(B1, 0, 1); PG8_STAGE(PG8_SB(0, 0), b2, voffB);
            PG8_BAR; PG8_WAIT_L(0); PG8_MMA(0, 1, At, B1); PG8_BAR;
            PG8_LDA(At, 0, 1); PG8_STAGE(PG8_SA(0, 0), a2, voffA);
            PG8_BAR; PG8_WAIT_L(0); PG8_MMA(1, 0, At, B0); PG8_BAR; PG8_SCHED;
            PG8_STAGE(PG8_SB(0, 1), b2 + hstep, voffB);
            PG8_WAIT_V(6); PG8_BAR; PG8_MMA(1, 1, At, B1); PG8_BAR;
            PG8_LDB(B0, 1, 0); PG8_SCHED; PG8_LDA(At, 1, 0); PG8_STAGE(PG8_SA(0, 1), a2 + hstep, voffA);
            PG8_WAIT_L(8); PG8_BAR; PG8_WAIT_L(0); PG8_MMA(0, 0, At, B0); PG8_BAR; PG8_SCHED;
            PG8_LDB(B1, 1, 1); PG8_STAGE(PG8_SB(1, 0), b3, voffB);
            PG8_BAR; PG8_WAIT_L(0); PG8_MMA(0, 1, At, B1); PG8_BAR;
            PG8_LDA(At, 1, 1); PG8_STAGE(PG8_SA(1, 0), a3, voffA);
            PG8_BAR; PG8_WAIT_L(0); PG8_MMA(1, 0, At, B0); PG8_BAR; PG8_SCHED;
            PG8_STAGE(PG8_SB(1, 1), b3 + hstep, voffB);
            PG8_WAIT_V(6); PG8_BAR; PG8_MMA(1, 1, At, B1); PG8_BAR;
            }
        }
        if constexpr (ALIGN_EPI) { if (wr == 0) PG8_BAR; }
        if constexpr (!Epi::AFTER_DRAIN) { E(acc, cur, wr, wc, fr, fq); S.done(cur); }
        if (!has_next) break;
#pragma unroll
        for (int a = 0; a < 2; ++a)
#pragma unroll
            for (int b = 0; b < 2; ++b)
#pragma unroll
                for (int m = 0; m < 4; ++m)
#pragma unroll
                    for (int n = 0; n < 2; ++n) acc[a][b][m][n] = (f32x4){0.f, 0.f, 0.f, 0.f};
        cur = nxt; cA = nA; cB = nB; ++ui;
        if constexpr (ALIGN_EPI) { if (wr == 1) PG8_BAR; }
    }
    PG8_WAIT_V(0);
    if constexpr (!ALIGN_EPI) { if (wr == 0) PG8_BAR; }
    PG8_BAR;
    if constexpr (Epi::AFTER_DRAIN) { E.fused(acc, cur, wr, wc, fr, fq, lds, wid, lane); S.done(cur); }
#undef PG8_SA
#undef PG8_SB
#undef PG8_STAGE
#undef PG8_LDA
#undef PG8_LDB
#undef PG8_MMA
#undef PG8_WAIT_V
#undef PG8_WAIT_L
#undef PG8_BAR
#undef PG8_SCHED
}
}

constexpr int NWAVES = 8, NTHR = 512;
constexpr int M = 18432, MP = 16384, D = 1024, NPROJ = 2560, DFF = 2816, NGU = 5632, SEQ = 8192;
constexpr int NCHUNK = M / 64;
constexpr float RMS_EPS = 1e-6f, LOG2E = 1.4426950408889634f;
constexpr int BPROJ = 1792;
enum { I_XP = 0, I_XS, I_CAK, I_CAV, I_SBW, I_SBS, I_CCK, I_CCV, I_SDC, I_NMIX, I_NFFN, I_NFIN, I_T5, I_WINE, I_WOUTE, I_SINK, I_MU, I_W0, I_W2, I_A0, I_A2, I_G2,
       I_KK, I_KA, I_RK, I_LNXW, I_LNXB, I_V0, I_V1, I_V2, I_WINO, I_WOUTO, I_CREL, I_DWW, I_DWB, I_LNG, I_LNB, I_FG, I_FU, I_FD, N_IN };
constexpr size_t O_YP = 0, O_YS = O_YP + (size_t)MP * D, O_PAK = O_YS + (size_t)2048 * D, O_PAV = O_PAK + 65536, O_PBW = O_PAV + 65536, O_PBS = O_PBW + 131072,
                 O_PCK = O_PBS + 7168, O_PCV = O_PCK + 1048576, O_PDC = O_PCV + 1048576, O_SAK = O_PDC + 61440, O_SAV = O_SAK + 524288, O_SBW = O_SAV + 524288,
                 O_SBS = O_SBW + 2097152, O_SCK = O_SBS + 114688, O_SCV = O_SCK + 2097152, O_SDC = O_SCV + 2097152, O_END = O_SDC + 983040;
static_assert(O_END == 29740032, "output map");
constexpr size_t MiB = 1u << 20;
constexpr size_t WS_CTL = 0, CTL_ZERO_BYTES = 64 * 1024;
constexpr size_t WS_W = 1 * MiB, W1_OFF = 0, W2_OFF = (size_t)NPROJ * D * 2, W3_OFF = W2_OFF + (size_t)D * D * 2, W4_OFF = W3_OFF + (size_t)NGU * D * 2, WL_STRIDE = W4_OFF + (size_t)D * DFF * 2;
constexpr size_t WS_XB = 96 * MiB;
constexpr size_t WS_P = 132 * MiB;
constexpr size_t WS_MIX = 222 * MiB;
constexpr size_t WS_H = WS_P;
constexpr size_t WS_V0 = 258 * MiB, WS_V1 = 276 * MiB, WS_R = 294 * MiB, WS_EM1 = 312 * MiB, WS_KH = 330 * MiB, WS_AA = 348 * MiB, WS_BB = 366 * MiB;
constexpr size_t WS_PHI = WS_P, WS_GAM = WS_P + 18 * MiB, WS_PSI = WS_P + 36 * MiB, WS_OME = WS_P + 54 * MiB, WS_SC = WS_P + 72 * MiB;
constexpr size_t WS_BONUS = 384 * MiB, WS_SS1 = WS_BONUS + (size_t)M * 8 * 4, WS_SS2 = WS_SS1 + (size_t)M * 16 * 4, WS_END = 387 * MiB;
static_assert(WS_W + 4 * WL_STRIDE <= WS_XB && WS_XB + (size_t)M * D * 2 <= WS_P && WS_P + (size_t)M * NPROJ * 2 <= WS_MIX && WS_MIX + (size_t)M * D * 2 <= WS_V0, "ws map");
static_assert(WS_H + (size_t)M * DFF * 2 <= WS_V0 && WS_SS2 + (size_t)M * 16 * 4 <= WS_END && (size_t)M * 512 * 4 <= (size_t)M * D * 2, "ws map 2");
constexpr int RING_BYTES = 131072, LDSCTL_OFF = RING_BYTES, MISC_OFF = LDSCTL_OFF + 320, LDS_BYTES = 147456;

#define GAS __attribute__((address_space(1)))
#define LAS __attribute__((address_space(3)))
typedef unsigned short bf16;
typedef unsigned v4u __attribute__((ext_vector_type(4)));
typedef unsigned v2u __attribute__((ext_vector_type(2)));
typedef float f32x4 __attribute__((ext_vector_type(4)));
typedef float f32x16 __attribute__((ext_vector_type(16)));
typedef short bf16x8 __attribute__((ext_vector_type(8)));
typedef short s16x4 __attribute__((ext_vector_type(4)));
typedef GAS unsigned gu32;
#define RLX_AGENT __ATOMIC_RELAXED, __HIP_MEMORY_SCOPE_AGENT
#define LDS_WAIT() asm volatile("s_waitcnt lgkmcnt(0)" ::: "memory")
#define VM_WAIT() asm volatile("s_waitcnt vmcnt(0)" ::: "memory")
__device__ __forceinline__ unsigned f2bf(float f) { unsigned u = __builtin_bit_cast(unsigned, f); return (u + 0x7fffu + ((u >> 16) & 1u)) >> 16; }
__device__ __forceinline__ unsigned pk2(float lo, float hi) { return pg8::cvt_pk_bf16(lo, hi); }
__device__ __forceinline__ float bf2f(unsigned h) { return __uint_as_float(h << 16); }
__device__ __forceinline__ float bflo(unsigned w) { return __uint_as_float(w << 16); }
__device__ __forceinline__ float bfhi(unsigned w) { return __uint_as_float(w & 0xffff0000u); }
__device__ __forceinline__ float wave_sum(float v) {
#pragma unroll
    for (int o = 1; o < 64; o <<= 1) v += __shfl_xor(v, o);
    return v;
}
__device__ __forceinline__ float row_ss(const GAS float* ssp, int row) {
    const GAS f32x4* p = (const GAS f32x4*)(ssp + (size_t)row * 16); const f32x4 a = p[0], b = p[1], c = p[2], d = p[3];
    return (((a.x + a.y) + (a.z + a.w)) + ((b.x + b.y) + (b.z + b.w))) + (((c.x + c.y) + (c.z + c.w)) + ((d.x + d.y) + (d.z + d.w)));
}
__device__ __forceinline__ void st16_wt(GAS void* p, v4u v) { asm volatile("global_store_dwordx4 %0, %1, off sc0 sc1\n\ts_nop 1" :: "v"(p), "v"(v) : "memory"); }
__device__ __forceinline__ v2u ld8_sys(const void* p) { const unsigned long long x = __hip_atomic_load((const unsigned long long*)p, __ATOMIC_RELAXED, __HIP_MEMORY_SCOPE_SYSTEM); return (v2u){(unsigned)x, (unsigned)(x >> 32)}; }
__device__ __forceinline__ bf16x8 ld16_sys(const void* p) { const v2u a = ld8_sys(p), b = ld8_sys((const char*)p + 8); return __builtin_bit_cast(bf16x8, (v4u){a.x, a.y, b.x, b.y}); }
__device__ __forceinline__ void st8_wt(void* p, v2u v) { __hip_atomic_store((unsigned long long*)p, ((unsigned long long)v.y << 32) | v.x, __ATOMIC_RELAXED, __HIP_MEMORY_SCOPE_SYSTEM); }
__device__ __forceinline__ float sigmoidf_(float x) { return 1.0f / (1.0f + __expf(-x)); }

#define XB_TMO      128
#define XB_XCNT(j)  (256  + 64 * (j))
#define XB_XSUB(j)  (1280 + 64 * (j))
#define XB_XGEN(j)  (2304 + 64 * (j))
#define XB_TOP      3328
#define XB_TOPGEN   3392
#define XCD_BAR_WORDS 3456
#define XB_SPIN_CAP (1u << 22)
__device__ __forceinline__ unsigned xb_ld(unsigned* p)              { return __hip_atomic_load(p, __ATOMIC_RELAXED, __HIP_MEMORY_SCOPE_AGENT); }
__device__ __forceinline__ unsigned xb_add(unsigned* p, unsigned v) { return __hip_atomic_fetch_add(p, v, __ATOMIC_RELAXED, __HIP_MEMORY_SCOPE_AGENT); }
__device__ __forceinline__ unsigned xb_xcc_id() { return (unsigned)__builtin_amdgcn_s_getreg((3 << 11) | 20) & 0xFu; }
#define XB_SPIN(cond, bar) do { unsigned _sp = 0; while (cond) { __builtin_amdgcn_s_sleep(1); \
    if ((++_sp & 255u) == 0u) { if (xb_ld(&(bar)[XB_TMO])) break; if (_sp > XB_SPIN_CAP) { atomicAdd(&(bar)[XB_TMO], 1u); break; } } } } while (0)
struct XcdBarrier { unsigned* bar; unsigned x; volatile LAS unsigned* st; };
__device__ __forceinline__ XcdBarrier xcd_barrier_post(unsigned* bar, volatile LAS unsigned* st) {
    XcdBarrier b; b.bar = bar; b.x = xb_xcc_id(); b.st = st;
    if (threadIdx.x == 0) (void)xb_add(&bar[XB_XCNT(b.x)], 1u);
    return b;
}
__device__ __forceinline__ void xcd_barrier_complete(unsigned* bar, unsigned x, unsigned& nloc, unsigned& nx) {
    const unsigned G = gridDim.x * gridDim.y * gridDim.z;
    unsigned sum, cnt, mine, sp = 0u;
    for (;;) {
        sum = 0u; cnt = 0u; mine = 0u;
#pragma unroll
        for (unsigned j = 0; j < 16; ++j) { const unsigned c = xb_ld(&bar[XB_XCNT(j)]); sum += c; cnt += (c > 0u) ? 1u : 0u; mine = (j == x) ? c : mine; }
        if (sum == G) break;
        __builtin_amdgcn_s_sleep(1);
        if ((++sp & 255u) == 0u) { if (xb_ld(&bar[XB_TMO])) break; if (sp > XB_SPIN_CAP) { atomicAdd(&bar[XB_TMO], 1u); break; } }
    }
    nloc = mine > 0u ? mine : 1u; nx = cnt > 0u ? cnt : 1u;
}
__device__ __forceinline__ void xcd_barrier(const XcdBarrier& b) {
    asm volatile("s_waitcnt vmcnt(0)" ::: "memory");
    __syncthreads();
    if (threadIdx.x == 0) {
        unsigned* bar = b.bar;
        __builtin_amdgcn_s_waitcnt(0);
        unsigned nloc = b.st[0], nx = b.st[1];
        if (nloc == 0u) { xcd_barrier_complete(bar, b.x, nloc, nx); b.st[0] = nloc; b.st[1] = nx; }
        const unsigned old = xb_add(&bar[XB_XSUB(b.x)], 1u);
        const unsigned gen = old / nloc;
        if (old + 1u == (gen + 1u) * nloc) {
            __builtin_amdgcn_fence(__ATOMIC_RELEASE, "agent");
            asm volatile("s_waitcnt vmcnt(0)" ::: "memory");
            const unsigned og = xb_add(&bar[XB_TOP], 1u);
            const unsigned tg = og / nx;
            if (og + 1u == (tg + 1u) * nx) xb_add(&bar[XB_TOPGEN], 1u);
            else XB_SPIN(xb_ld(&bar[XB_TOPGEN]) == tg, bar);
            __builtin_amdgcn_fence(__ATOMIC_ACQUIRE, "agent");
            xb_add(&bar[XB_XGEN(b.x)], 1u);
            asm volatile("s_waitcnt vmcnt(0)" ::: "memory");
        } else {
            XB_SPIN(xb_ld(&bar[XB_XGEN(b.x)]) == gen, bar);
            __builtin_amdgcn_fence(__ATOMIC_ACQUIRE, "agent");
            asm volatile("s_waitcnt vmcnt(0)" ::: "memory");
        }
    }
    __syncthreads();
}

struct Args { const float* in[N_IN]; float* out; unsigned char* ws; int ph_lo, ph_hi, use_bar, pad; };
struct Frame {
    LAS unsigned char* lds;
    int tid, lane, wave, G, bid, vsel, nostate;
    GAS float* out; GAS unsigned char* ws;
};

typedef __attribute__((address_space(4))) const char* kargp_t;
__device__ __forceinline__ const float* inp_(int idx) {
    kargp_t kp = (kargp_t)__builtin_amdgcn_kernarg_segment_ptr(); asm volatile("" : "+s"(kp));
    const float* q = *(const float* const __attribute__((address_space(4)))*)(kp + 8 * idx);
    return (const float*)(const GAS float*)q;
}
#define inp(F, idx) inp_(idx)
namespace pg8 {
struct EpiProj {
    static constexpr bool PERM = true, AFTER_DRAIN = false;
    GAS unsigned char* ws;
    __device__ __forceinline__ void operator()(const f32x4 (&acc)[2][2][4][2], const Unit& u, int wr, int wc, int fr, int fq) const {
        GAS bf16_t* P = (GAS bf16_t*)(ws + WS_P); const GAS float* ss = (const GAS float*)(ws + WS_SS2);
        const int row0 = u.pm * BM + wr * 64 + fr, col0 = u.pn * BM + wc * 32 + 8 * fq;
#pragma unroll
        for (int ai = 0; ai < 2; ++ai)
#pragma unroll
            for (int m = 0; m < 4; ++m) {
                const int row = row0 + ai * HALF + m * 16;
                const float sc = 1.0f / sqrtf(row_ss(ss, row) * (1.0f / 1024.0f) + 1e-6f);
#pragma unroll
                for (int bj = 0; bj < 2; ++bj) {
                    const f32x4 v0 = acc[ai][bj][m][0] * sc, v1 = acc[ai][bj][m][1] * sc;
                    u32x4 w; w.x = cvt_pk_bf16(v0[0], v0[1]); w.y = cvt_pk_bf16(v0[2], v0[3]); w.z = cvt_pk_bf16(v1[0], v1[1]); w.w = cvt_pk_bf16(v1[2], v1[3]);
                    *(GAS u32x4*)(P + (size_t)row * 2560 + col0 + bj * HALF) = w;
                }
                asm volatile("" ::: "memory");
            }
    }
};
struct EpiResid {
    static constexpr bool PERM = true, AFTER_DRAIN = false;
    GAS float* X; GAS unsigned char* ws; size_t ssoff;
    __device__ __forceinline__ void operator()(const f32x4 (&acc)[2][2][4][2], const Unit& u, int wr, int wc, int fr, int fq) const {
        GAS bf16_t* XB = (GAS bf16_t*)(ws + WS_XB); GAS float* ss = (GAS float*)(ws + ssoff);
        const int row0 = u.pm * BM + wr * 64 + fr, col0 = u.pn * BM + wc * 32 + 8 * fq;
#pragma unroll
        for (int ai = 0; ai < 2; ++ai)
#pragma unroll
            for (int m = 0; m < 4; ++m) {
                const int row = row0 + ai * HALF + m * 16; float q = 0.f;
#pragma unroll
                for (int bj = 0; bj < 2; ++bj) {
                    const int col = col0 + bj * HALF;
                    GAS float* xp = X + (size_t)row * 1024 + col;
                    f32x4 v0 = *(const GAS f32x4*)xp + acc[ai][bj][m][0], v1 = *(const GAS f32x4*)(xp + 4) + acc[ai][bj][m][1];
                    *(GAS f32x4*)xp = v0; *(GAS f32x4*)(xp + 4) = v1;
                    u32x4 w; w.x = cvt_pk_bf16(v0[0], v0[1]); w.y = cvt_pk_bf16(v0[2], v0[3]); w.z = cvt_pk_bf16(v1[0], v1[1]); w.w = cvt_pk_bf16(v1[2], v1[3]);
                    *(GAS u32x4*)(XB + (size_t)row * 1024 + col) = w;
                    q += (v0[0] * v0[0] + v0[1] * v0[1]) + (v0[2] * v0[2] + v0[3] * v0[3]) + (v1[0] * v1[0] + v1[1] * v1[1]) + (v1[2] * v1[2] + v1[3] * v1[3]);
                }
                q += __shfl_xor(q, 16); q += __shfl_xor(q, 32);
                if (fq == 0) ss[(size_t)row * 16 + u.pn * 4 + wc] = q;
                asm volatile("" ::: "memory");
            }
    }
};
struct EpiSwiglu {
    static constexpr bool PERM = true, AFTER_DRAIN = false;
    GAS unsigned char* ws;
    __device__ __forceinline__ void operator()(const f32x4 (&acc)[2][2][4][2], const Unit& u, int wr, int wc, int fr, int fq) const {
        GAS bf16_t* H = (GAS bf16_t*)(ws + WS_H); const GAS float* ss = (const GAS float*)(ws + WS_SS1);
        const int row0 = u.pm * BM + wr * 64 + fr, col0 = u.pn * HALF + wc * 32 + 8 * fq;
#pragma unroll
        for (int ai = 0; ai < 2; ++ai)
#pragma unroll
            for (int m = 0; m < 4; ++m) {
                const int row = row0 + ai * HALF + m * 16;
                const float sc = 1.0f / sqrtf(row_ss(ss, row) * (1.0f / 1024.0f) + 1e-6f);
                float h[8];
#pragma unroll
                for (int n = 0; n < 2; ++n)
#pragma unroll
                    for (int e = 0; e < 4; ++e) { const float g = acc[ai][0][m][n][e] * sc, up = acc[ai][1][m][n][e] * sc; h[n * 4 + e] = g / (1.0f + __expf(-g)) * up; }
                u32x4 w; w.x = cvt_pk_bf16(h[0], h[1]); w.y = cvt_pk_bf16(h[2], h[3]); w.z = cvt_pk_bf16(h[4], h[5]); w.w = cvt_pk_bf16(h[6], h[7]);
                *(GAS u32x4*)(H + (size_t)row * 2816 + col0) = w;
            }
    }
};
}

__device__ __forceinline__ void p0_transpose_item(const float* W, int K, int N, const float* sc, bf16* WT, int mode, LAS float* scr, int item, int lane) {
    const int nblk = N / 32, kb = item / nblk, nb = item % nblk, k0 = 64 * kb, n0 = 32 * nb;
    const int drow0 = (mode == 0) ? n0 : (256 * (n0 >> 7) + (n0 & 127) + (mode == 2 ? 128 : 0));
#pragma unroll 8
    for (int i = 0; i < 32; ++i) { const int kk = 2 * i + (lane >> 5); float v = W[(size_t)(k0 + kk) * N + n0 + (lane & 31)]; if (sc) v *= sc[k0 + kk]; scr[kk * 33 + (lane & 31)] = v; }
    LDS_WAIT(); asm volatile("" ::: "memory");
    const int c = lane & 7;
#pragma unroll
    for (int j = 0; j < 4; ++j) { const int n = (lane >> 3) + 8 * j; const LAS float* s = scr + (8 * c) * 33 + n;
        v4u o; o.x = pk2(s[0 * 33], s[1 * 33]); o.y = pk2(s[2 * 33], s[3 * 33]); o.z = pk2(s[4 * 33], s[5 * 33]); o.w = pk2(s[6 * 33], s[7 * 33]);
        *(GAS v4u*)(WT + (size_t)(drow0 + n) * K + k0 + 8 * c) = o; }
    LDS_WAIT(); asm volatile("" ::: "memory");
}
__device__ __forceinline__ void phase_prologue(Frame& F) {
    LAS float* scr = (LAS float*)(F.lds + F.wave * 16384);
    const int gw = F.bid * NWAVES + F.wave, NGW = F.G * NWAVES;
    constexpr int I1 = 16 * 80, I2 = 16 * 32, I3 = 16 * 88, I4 = 44 * 32, IL = I1 + I2 + 2 * I3 + I4;
    for (int it = gw; it < 4 * IL; it += NGW) {
        const int L = it / IL; int r = it - L * IL; const int j = L >> 1, odd = L & 1;
        unsigned char* wl = (unsigned char*)(F.ws + WS_W + (size_t)L * WL_STRIDE);
        if (r < I1) { p0_transpose_item(inp(F, odd ? I_WINO : I_WINE) + (size_t)j * D * NPROJ, D, NPROJ, inp(F, I_NMIX) + L * D, (bf16*)(wl + W1_OFF), 0, scr, r, F.lane); continue; } r -= I1;
        if (r < I2) { p0_transpose_item(inp(F, odd ? I_WOUTO : I_WOUTE) + (size_t)j * D * D, D, D, nullptr, (bf16*)(wl + W2_OFF), 0, scr, r, F.lane); continue; } r -= I2;
        if (r < I3) { p0_transpose_item(inp(F, I_FG) + (size_t)L * D * DFF, D, DFF, inp(F, I_NFFN) + L * D, (bf16*)(wl + W3_OFF), 1, scr, r, F.lane); continue; } r -= I3;
        if (r < I3) { p0_transpose_item(inp(F, I_FU) + (size_t)L * D * DFF, D, DFF, inp(F, I_NFFN) + L * D, (bf16*)(wl + W3_OFF), 2, scr, r, F.lane); continue; } r -= I3;
        p0_transpose_item(inp(F, I_FD) + (size_t)L * DFF * D, DFF, D, nullptr, (bf16*)(wl + W4_OFF), 0, scr, r, F.lane);
    }
    bf16* XB = (bf16*)(F.ws + WS_XB); float* ss2 = (float*)(F.ws + WS_SS2);
    for (int m = gw; m < M; m += NGW) {
        const float* xrow = (m < MP) ? inp(F, I_XP) + (size_t)m * D : inp(F, I_XS) + (size_t)(m - MP) * D;
        const GAS f32x4* xr = (const GAS f32x4*)xrow + F.lane;
        GAS f32x4* xo = (GAS f32x4*)(F.out + (size_t)m * D) + F.lane;
        GAS v2u* xb = (GAS v2u*)(XB + (size_t)m * D) + F.lane;
        float s = 0.f;
#pragma unroll
        for (int q = 0; q < 4; ++q) { const f32x4 v = xr[64 * q]; xo[64 * q] = v; s += (v.x * v.x + v.y * v.y) + (v.z * v.z + v.w * v.w); v2u o; o.x = pk2(v.x, v.y); o.y = pk2(v.z, v.w); xb[64 * q] = o; }
        s = wave_sum(s);
        if (F.lane < 16) ss2[(size_t)m * 16 + F.lane] = (F.lane == 0) ? s : 0.f;
    }
}
__device__ __forceinline__ void zero_f32(Frame& F, float* p, int n) { if (F.bid * NTHR < n) p[F.bid * NTHR + F.tid] = 0.f; }

constexpr int KS_STRIDE = 144;
constexpr int SLOT_BYTES = 64 * KS_STRIDE;
constexpr int ATT_K_OFF = 0, ATT_V_OFF = 4 * SLOT_BYTES, ATT_TAB_OFF = 8 * SLOT_BYTES, ATT_TAB_N = 640;
__device__ __forceinline__ int t5_bucket_dev(int rel) {
    const int n = rel < 0 ? -rel : rel;
    const int l = n < 8 ? n : (n < 12 ? 8 : (n < 16 ? 9 : (n < 23 ? 10 : (n < 32 ? 11 : (n < 46 ? 12 : (n < 64 ? 13 : (n < 91 ? 14 : 15)))))));
    return (rel > 0 ? 16 : 0) + l;
}
template <bool ISC>
__device__ __forceinline__ void attn_unit(Frame& F, int j, int unit) {
    const int tid = F.tid, lane = F.lane, w = F.wave, r32 = lane & 31, hi = lane >> 5;
    const int c = unit >> 1, sub = unit & 1;
    const bool samp = c >= 256; const int bs = c - 256, cl = c & 127;
    const int g = w >> 1, half = w & 1;
    const int head = sub * 4 + g;
    const int NLEFT = ISC ? 8 : 2;
    const bf16* P = (const bf16*)(F.ws + WS_P);
    LAS unsigned char* lds = F.lds;
    LAS float* tab = (LAS float*)(lds + ATT_TAB_OFF);
    if (ISC) { const float* tb = inp(F, I_CREL) + (size_t)j * 8 * 257;
        for (int e = tid; e < 4 * ATT_TAB_N; e += NTHR) { const int gg = e / ATT_TAB_N, i = e - gg * ATT_TAB_N; int dist = i - 63; dist = dist < -128 ? -128 : (dist > 128 ? 128 : dist);
            tab[e] = tb[(sub * 4 + gg) * 257 + dist + 128] * LOG2E; }
    } else { const float* tb = inp(F, I_T5);
        for (int e = tid; e < 4 * ATT_TAB_N; e += NTHR) { const int gg = e / ATT_TAB_N, i = e - gg * ATT_TAB_N; const int rel = i - 191;
            tab[e] = (i < 255) ? tb[t5_bucket_dev(rel) * 8 + (sub * 4 + gg)] * LOG2E : 0.f; }
    }
    const int tq = 32 * half + r32;
    bf16x8 qf[4];
    { const bf16* qp = P + (size_t)(64 * c + tq) * NPROJ + head * 64 + 8 * hi;
#pragma unroll
      for (int ks = 0; ks < 4; ++ks) qf[ks] = *(const bf16x8*)(qp + 16 * ks); }
    float mrun, lrun;
    if (ISC) { mrun = -1e30f; lrun = 0.f; } else { mrun = inp(F, I_SINK)[j * 8 + head] * LOG2E; lrun = 1.f; }
    f32x16 o0, o1;
#pragma unroll
    for (int r = 0; r < 16; ++r) { o0[r] = 0.f; o1[r] = 0.f; }
    const int slot = ISC ? g : 0;
    LAS unsigned char* Kb = lds + ATT_K_OFF + slot * SLOT_BYTES;
    LAS unsigned char* Vb = lds + ATT_V_OFF + slot * SLOT_BYTES;
    const LAS float* mytab = tab + g * ATT_TAB_N;
    const int skey = tid >> 3, sdch = tid & 7;
    for (int tau = 0; tau <= NLEFT; ++tau) {
        if (!samp && cl - NLEFT + tau < 0) continue;
        __syncthreads();
        const bool fromcache = samp && tau < NLEFT;
#pragma unroll
        for (int s = 0; s < (ISC ? 4 : 1); ++s) {
            float kv[8], vv[8];
            if (fromcache) {
                const int pos = 64 * tau + skey;
                const float* kp; const float* vp;
                if (ISC) { const size_t o = ((size_t)(j * 32 + bs) * 512 + pos) * 512 + (sub * 4 + s) * 64 + sdch * 8; kp = inp(F, I_CCK) + o; vp = inp(F, I_CCV) + o; }
                else     { const size_t o = ((size_t)(j * 32 + bs) * 128 + pos) * 128 + sub * 64 + sdch * 8; kp = inp(F, I_CAK) + o; vp = inp(F, I_CAV) + o; }
                const f32x4 a0 = *(const f32x4*)kp, a1 = *(const f32x4*)(kp + 4), b0 = *(const f32x4*)vp, b1 = *(const f32x4*)(vp + 4);
                kv[0] = a0.x; kv[1] = a0.y; kv[2] = a0.z; kv[3] = a0.w; kv[4] = a1.x; kv[5] = a1.y; kv[6] = a1.z; kv[7] = a1.w;
                vv[0] = b0.x; vv[1] = b0.y; vv[2] = b0.z; vv[3] = b0.w; vv[4] = b1.x; vv[5] = b1.y; vv[6] = b1.z; vv[7] = b1.w;
            } else {
                const int krow = 64 * (c - NLEFT + tau) + skey;
                const bf16* kp = P + (size_t)krow * NPROJ + (ISC ? (512 + (sub * 4 + s) * 64) : (512 + sub * 64)) + sdch * 8;
                const bf16* vp = P + (size_t)krow * NPROJ + (ISC ? (1024 + (sub * 4 + s) * 64) : (640 + sub * 64)) + sdch * 8;
                const v4u a = *(const v4u*)kp, b = *(const v4u*)vp;
                kv[0] = bflo(a.x); kv[1] = bfhi(a.x); kv[2] = bflo(a.y); kv[3] = bfhi(a.y); kv[4] = bflo(a.z); kv[5] = bfhi(a.z); kv[6] = bflo(a.w); kv[7] = bfhi(a.w);
                vv[0] = bflo(b.x); vv[1] = bfhi(b.x); vv[2] = bflo(b.y); vv[3] = bfhi(b.y); vv[4] = bflo(b.z); vv[5] = bfhi(b.z); vv[6] = bflo(b.w); vv[7] = bfhi(b.w);
            }
            v4u kw; kw.x = pk2(kv[0], kv[1]); kw.y = pk2(kv[2], kv[3]); kw.z = pk2(kv[4], kv[5]); kw.w = pk2(kv[6], kv[7]);
            *(LAS v4u*)(lds + ATT_K_OFF + s * SLOT_BYTES + skey * KS_STRIDE + sdch * 16) = kw;
#pragma unroll
            for (int e = 0; e < 8; ++e) *(LAS unsigned short*)(lds + ATT_V_OFF + s * SLOT_BYTES + (sdch * 8 + e) * KS_STRIDE + skey * 2) = (unsigned short)f2bf(vv[e]);
        }
        __syncthreads();
        f32x16 s0, s1;
#pragma unroll
        for (int r = 0; r < 16; ++r) { s0[r] = 0.f; s1[r] = 0.f; }
#pragma unroll
        for (int ks = 0; ks < 4; ++ks) {
            const bf16x8 k0 = *(const LAS bf16x8*)(Kb + r32 * KS_STRIDE + (16 * ks + 8 * hi) * 2);
            const bf16x8 k1 = *(const LAS bf16x8*)(Kb + (32 + r32) * KS_STRIDE + (16 * ks + 8 * hi) * 2);
            s0 = __builtin_amdgcn_mfma_f32_32x32x16_bf16(k0, qf[ks], s0, 0, 0, 0);
            s1 = __builtin_amdgcn_mfma_f32_32x32x16_bf16(k1, qf[ks], s1, 0, 0, 0);
        }
        const float qscale = 0.125f * LOG2E;
        float mt = -1e30f;
#pragma unroll
        for (int r = 0; r < 16; ++r) {
            const int key = (r & 3) + 8 * (r >> 2) + 4 * hi;
            const int i0 = ISC ? (tq - key + 63 + (8 - tau) * 64) : (64 * tau + key - tq + 63);
            const int i1 = ISC ? (i0 - 32) : (i0 + 32);
            s0[r] = s0[r] * qscale + mytab[i0]; s1[r] = s1[r] * qscale + mytab[i1];
            mt = fmaxf(mt, fmaxf(s0[r], s1[r]));
        }
        mt = fmaxf(mt, __shfl_xor(mt, 32));
        const float mnew = fmaxf(mrun, mt), alpha = exp2f(mrun - mnew);
        float ls = 0.f;
#pragma unroll
        for (int r = 0; r < 16; ++r) { s0[r] = exp2f(s0[r] - mnew); s1[r] = exp2f(s1[r] - mnew); ls += s0[r] + s1[r]; }
        ls += __shfl_xor(ls, 32);
        lrun = lrun * alpha + ls; mrun = mnew;
#pragma unroll
        for (int r = 0; r < 16; ++r) { o0[r] *= alpha; o1[r] *= alpha; }
#pragma unroll
        for (int kb = 0; kb < 2; ++kb)
#pragma unroll
            for (int s = 0; s < 2; ++s) {
                const f32x16& sv = kb ? s1 : s0;
                v4u pw; pw.x = pg8::cvt_pk_bf16(sv[8 * s + 0], sv[8 * s + 1]); pw.y = pg8::cvt_pk_bf16(sv[8 * s + 2], sv[8 * s + 3]);
                        pw.z = pg8::cvt_pk_bf16(sv[8 * s + 4], sv[8 * s + 5]); pw.w = pg8::cvt_pk_bf16(sv[8 * s + 6], sv[8 * s + 7]);
                const bf16x8 pf = __builtin_bit_cast(bf16x8, pw);
                const int koff = (32 * kb + 16 * s + 4 * hi) * 2;
                const v2u a0 = *(const LAS v2u*)(Vb + r32 * KS_STRIDE + koff), a1 = *(const LAS v2u*)(Vb + r32 * KS_STRIDE + koff + 16);
                const v2u c0 = *(const LAS v2u*)(Vb + (32 + r32) * KS_STRIDE + koff), c1 = *(const LAS v2u*)(Vb + (32 + r32) * KS_STRIDE + koff + 16);
                v4u va; va.x = a0.x; va.y = a0.y; va.z = a1.x; va.w = a1.y;
                v4u vc; vc.x = c0.x; vc.y = c0.y; vc.z = c1.x; vc.w = c1.y;
                o0 = __builtin_amdgcn_mfma_f32_32x32x16_bf16(__builtin_bit_cast(bf16x8, va), pf, o0, 0, 0, 0);
                o1 = __builtin_amdgcn_mfma_f32_32x32x16_bf16(__builtin_bit_cast(bf16x8, vc), pf, o1, 0, 0, 0);
            }
    }
    const float inv = 1.0f / lrun;
    bf16* MIX = (bf16*)(F.ws + WS_MIX);
    bf16* op = MIX + (size_t)(64 * c + tq) * D + head * 64 + 4 * hi;
#pragma unroll
    for (int q4 = 0; q4 < 4; ++q4) {
        v2u a; a.x = pk2(o0[4 * q4] * inv, o0[4 * q4 + 1] * inv); a.y = pk2(o0[4 * q4 + 2] * inv, o0[4 * q4 + 3] * inv);
        v2u b; b.x = pk2(o1[4 * q4] * inv, o1[4 * q4 + 1] * inv); b.y = pk2(o1[4 * q4 + 2] * inv, o1[4 * q4 + 3] * inv);
        *(v2u*)(op + 8 * q4) = a; *(v2u*)(op + 32 + 8 * q4) = b;
    }
    __syncthreads();
}

__device__ __forceinline__ void copy8(const bf16* src, float* dst) {
    const v4u a = *(const v4u*)src;
    f32x4 lo, hi; lo.x = bflo(a.x); lo.y = bfhi(a.x); lo.z = bflo(a.y); lo.w = bfhi(a.y); hi.x = bflo(a.z); hi.y = bfhi(a.z); hi.z = bflo(a.w); hi.w = bfhi(a.w);
    *(f32x4*)dst = lo; *(f32x4*)(dst + 4) = hi;
}
__device__ __forceinline__ void side_outputs(Frame& F, int j, int odd) {
    const int gw = F.bid * NWAVES + F.wave, NGW = F.G * NWAVES, lane = F.lane;
    const bf16* P = (const bf16*)(F.ws + WS_P);
    const int win = odd ? 512 : 128, pitch = odd ? 512 : 128, nrow = 2 * win + 2048, vcol = odd ? 1024 : 640;
    for (int it = gw; it < 2 * nrow; it += NGW) {
        const int isv = it & 1, r = it >> 1; size_t srow, doff;
        if (r < 2 * win) { const int b = r / win, tt = r - b * win; srow = (size_t)b * SEQ + (SEQ - win) + tt;
            doff = (odd ? (isv ? O_PCV : O_PCK) : (isv ? O_PAV : O_PAK)) + ((size_t)(j * 2 + b) * win + tt) * pitch; }
        else { const int rs = r - 2 * win; srow = (size_t)MP + rs; doff = (odd ? (isv ? O_SCV : O_SCK) : (isv ? O_SAV : O_SAK)) + ((size_t)j * 2048 + rs) * pitch; }
        if (lane * 8 < pitch) copy8(P + srow * NPROJ + (isv ? vcol : 512) + lane * 8, (float*)(F.out + doff + lane * 8));
    }
    if (!odd) for (int it = gw; it < 34 * 4; it += NGW) {
        const int r = it >> 2, q = it & 3; size_t srow, doff;
        if (r < 2) { srow = (size_t)r * SEQ + SEQ - 1; doff = O_PBS + (size_t)(j * 2 + r) * BPROJ; } else { srow = (size_t)MP + (r - 2) * 64 + 63; doff = O_SBS + (size_t)(j * 32 + (r - 2)) * BPROJ; }
        if (lane < 56) copy8(P + srow * NPROJ + 768 + q * 448 + lane * 8, (float*)(F.out + doff + q * 448 + lane * 8));
    }
}
__device__ __forceinline__ void conv_unit(Frame& F, int j, int unit) {
    const int tid = F.tid, lane = F.lane, w = F.wave, ch = tid;
    const int row0 = 32 * unit, c = row0 >> 6; const bool samp = c >= 256; const int bs = c - 256, bp = c >> 7;
    const int t0 = samp ? (row0 & 63) : (row0 & 8191);
    const bf16* P = (const bf16*)(F.ws + WS_P);
    LAS float* zbuf = (LAS float*)F.lds;
    float uu[62];
#pragma unroll
    for (int i = 0; i < 62; ++i) {
        const int tl = t0 - 30 + i;
        float u = 0.f;
        if (tl >= 0) { const bf16* p = P + (size_t)(row0 - 30 + i) * NPROJ + 1536 + ch; const float a = bf2f(p[0]), gt = bf2f(p[512]); u = a * sigmoidf_(gt); }
        else if (samp) u = inp(F, I_SDC)[((size_t)(j * 32 + bs) * 30 + (30 + tl)) * 512 + ch];
        uu[i] = u;
    }
    float dw[31];
#pragma unroll
    for (int k = 0; k < 31; ++k) dw[k] = inp(F, I_DWW)[((size_t)j * 31 + k) * 512 + ch];
    const float db = inp(F, I_DWB)[j * 512 + ch];
#pragma unroll
    for (int t = 0; t < 32; ++t) {
        float z = db;
#pragma unroll
        for (int k = 0; k < 31; ++k) z += dw[k] * uu[t + k];
        zbuf[t * 512 + ch] = z;
        const int tl = t0 + t;
        if (samp) { if (tl >= 34) F.out[O_SDC + ((size_t)(j * 32 + bs) * 30 + (tl - 34)) * 512 + ch] = uu[30 + t]; }
        else if (tl >= 8162) F.out[O_PDC + ((size_t)(j * 2 + bp) * 30 + (tl - 8162)) * 512 + ch] = uu[30 + t];
    }
    __syncthreads();
    bf16* MIX = (bf16*)(F.ws + WS_MIX);
    const float* lg = inp(F, I_LNG) + j * 512; const float* lb = inp(F, I_LNB) + j * 512;
#pragma unroll
    for (int tt = 0; tt < 4; ++tt) {
        const int t = 4 * w + tt; float v[8]; float s = 0.f;
#pragma unroll
        for (int k = 0; k < 8; ++k) { v[k] = zbuf[t * 512 + lane + 64 * k]; s += v[k]; }
        const float mean = wave_sum(s) * (1.0f / 512.0f); float q = 0.f;
#pragma unroll
        for (int k = 0; k < 8; ++k) { v[k] -= mean; q += v[k] * v[k]; }
        const float rstd = 1.0f / sqrtf(wave_sum(q) * (1.0f / 512.0f) + 1e-5f);
#pragma unroll
        for (int k = 0; k < 8; ++k) { const int cc = lane + 64 * k; const float zn = v[k] * rstd * lg[cc] + lb[cc]; MIX[(size_t)(row0 + t) * D + 512 + cc] = (bf16)f2bf(zn * sigmoidf_(zn)); }
    }
    __syncthreads();
}

constexpr int B1_T = 16;
__device__ __forceinline__ void rwkv_b1_unit(Frame& F, int j, int unit) {
    const int tid = F.tid, lane = F.lane, w = F.wave;
    const int row0 = B1_T * unit, c = row0 >> 6; const bool samp = c >= 256; const int bs = c - 256;
    const int t0 = samp ? (row0 & 63) : (row0 & 8191);
    const bf16* P = (const bf16*)(F.ws + WS_P);
    LAS float* xs = (LAS float*)F.lds;
    LAS float* lv1 = xs + B1_T * BPROJ;
    const float* mu = inp(F, I_MU) + j * BPROJ;
    for (int cc = tid; cc < BPROJ; cc += NTHR) {
        float prev;
        if (t0 == 0) prev = samp ? inp(F, I_SBS)[(size_t)(j * 32 + bs) * BPROJ + cc] : 0.f;
        else prev = bf2f(P[(size_t)(row0 - 1) * NPROJ + 768 + cc]);
        const float m_ = mu[cc];
#pragma unroll
        for (int t = 0; t < B1_T; ++t) { const float cur = bf2f(P[(size_t)(row0 + t) * NPROJ + 768 + cc]); float v = cur + (prev - cur) * m_;
            if (cc >= 512 && cc < 576) v = tanhf(v); else if (cc >= 1664) v = sigmoidf_(v);
            xs[t * BPROJ + cc] = v; prev = cur; }
    }
    __syncthreads();
    if (j > 0) {
        const int t = tid >> 5, q = tid & 31; const float* v1 = inp(F, I_V1) + (size_t)(j - 1) * 512 * 32; float s = 0.f;
        for (int k = 0; k < 512; ++k) s += xs[t * BPROJ + 1088 + k] * v1[k * 32 + q];
        lv1[t * 32 + q] = s;
    }
    __syncthreads();
    const int ch = tid;
    float lw[B1_T], la[B1_T], lgt[B1_T], lv[B1_T];
#pragma unroll
    for (int t = 0; t < B1_T; ++t) { lw[t] = 0.f; la[t] = 0.f; lgt[t] = 0.f; lv[t] = 0.f; }
    { const float* w2 = inp(F, I_W2) + (size_t)j * 64 * 512; const float* a2 = inp(F, I_A2) + (size_t)j * 64 * 512; const float* g2 = inp(F, I_G2) + (size_t)j * 128 * 512;
      for (int k = 0; k < 64; k += 4) {
          const float wa = w2[(k + 0) * 512 + ch], wb = w2[(k + 1) * 512 + ch], wc_ = w2[(k + 2) * 512 + ch], wd = w2[(k + 3) * 512 + ch];
          const float aa = a2[(k + 0) * 512 + ch], ab = a2[(k + 1) * 512 + ch], ac = a2[(k + 2) * 512 + ch], ad = a2[(k + 3) * 512 + ch];
#pragma unroll
          for (int t = 0; t < B1_T; ++t) { const f32x4 x = *(const LAS f32x4*)(xs + t * BPROJ + 512 + k); lw[t] += x.x * wa + x.y * wb + x.z * wc_ + x.w * wd;
                                           const f32x4 y = *(const LAS f32x4*)(xs + t * BPROJ + 1600 + k); la[t] += y.x * aa + y.y * ab + y.z * ac + y.w * ad; }
      }
      for (int k = 0; k < 128; k += 4) {
          const float ga = g2[(k + 0) * 512 + ch], gb = g2[(k + 1) * 512 + ch], gc = g2[(k + 2) * 512 + ch], gd = g2[(k + 3) * 512 + ch];
#pragma unroll
          for (int t = 0; t < B1_T; ++t) { const f32x4 x = *(const LAS f32x4*)(xs + t * BPROJ + 1664 + k); lgt[t] += x.x * ga + x.y * gb + x.z * gc + x.w * gd; }
      }
      if (j > 0) { const float* v2 = inp(F, I_V2) + (size_t)(j - 1) * 32 * 512;
          for (int k = 0; k < 32; k += 4) {
              const float va = v2[(k + 0) * 512 + ch], vb = v2[(k + 1) * 512 + ch], vc = v2[(k + 2) * 512 + ch], vd = v2[(k + 3) * 512 + ch];
#pragma unroll
              for (int t = 0; t < B1_T; ++t) { const f32x4 x = *(const LAS f32x4*)(lv1 + t * 32 + k); lv[t] += x.x * va + x.y * vb + x.z * vc + x.w * vd; }
          } }
    }
    const float w0 = inp(F, I_W0)[j * 512 + ch], a0 = inp(F, I_A0)[j * 512 + ch], kks = inp(F, I_KK)[j * 512 + ch], kas = inp(F, I_KA)[j * 512 + ch], rk = inp(F, I_RK)[j * 512 + ch];
    const float v0 = (j > 0) ? inp(F, I_V0)[(j - 1) * 512 + ch] : 0.f;
    bf16* Vcur = (bf16*)(F.ws + (j == 0 ? WS_V0 : WS_V1)); const bf16* Vfirst = (const bf16*)(F.ws + WS_V0);
    bf16* R = (bf16*)(F.ws + WS_R); bf16* EM1 = (bf16*)(F.ws + WS_EM1); bf16* KH = (bf16*)(F.ws + WS_KH); bf16* AA = (bf16*)(F.ws + WS_AA); bf16* BB = (bf16*)(F.ws + WS_BB);
    bf16* MIX = (bf16*)(F.ws + WS_MIX); float* BON = (float*)(F.ws + WS_BONUS);
#pragma unroll
    for (int t = 0; t < B1_T; ++t) {
        const size_t o = (size_t)(row0 + t) * 512 + ch;
        const float xw = w0 + lw[t];
        const float sp = (-xw > 20.f) ? -xw : log1pf(__expf(-xw));
        const float wl = -sp - 0.5f;
        const float em1 = -__expf(wl);
        const float a = sigmoidf_(a0 + la[t]);
        const float r = xs[t * BPROJ + ch], k = xs[t * BPROJ + 576 + ch]; float v = xs[t * BPROJ + 1088 + ch];
        if (j > 0) { const float vf = bf2f(Vfirst[o]); v = v + (vf - v) * sigmoidf_(v0 + lv[t]); }
        const float kkv = k * kks; const float nrm = sqrtf(wave_sum(kkv * kkv)); const float kk = kkv / fmaxf(nrm, 1e-12f);
        const float kh = k * (1.0f + (a - 1.0f) * kas);
        const float bon = wave_sum(r * kh * rk);
        R[o] = (bf16)f2bf(r); EM1[o] = (bf16)f2bf(em1); KH[o] = (bf16)f2bf(kh); AA[o] = (bf16)f2bf(-kk); BB[o] = (bf16)f2bf(kk * a); Vcur[o] = (bf16)f2bf(v);
        MIX[(size_t)(row0 + t) * D + 512 + ch] = (bf16)f2bf(lgt[t]);
        if (lane == 0) BON[(size_t)(row0 + t) * 8 + w] = bon;
    }
    __syncthreads();
}

constexpr int IMG_STRIDE = 144, IMG_BYTES = 64 * IMG_STRIDE;
typedef short v4i16_t __attribute__((ext_vector_type(4)));
__device__ __forceinline__ bf16x8 tr_frag(const LAS unsigned char* img, int k0, int c0, int lane) {
    const LAS unsigned char* p = img + (k0 + 8 * (lane >> 4) + ((lane & 15) >> 2)) * IMG_STRIDE + (c0 + 4 * (lane & 3)) * 2;
    const v4i16_t lo = __builtin_amdgcn_ds_read_tr16_b64_v4i16((LAS v4i16_t*)p);
    const v4i16_t hi = __builtin_amdgcn_ds_read_tr16_b64_v4i16((LAS v4i16_t*)(p + 4 * IMG_STRIDE));
    return (bf16x8){lo[0], lo[1], lo[2], lo[3], hi[0], hi[1], hi[2], hi[3]};
}
__device__ __forceinline__ bf16x8 row_frag(const LAS unsigned char* img, int k0, int r0, int lane) {
    return *(const LAS bf16x8*)(img + (r0 + (lane & 15)) * IMG_STRIDE + (k0 + 8 * (lane >> 4)) * 2);
}
template <bool ATR, bool BTR>
__device__ __forceinline__ f32x4 mm16(const LAS unsigned char* Aimg, int a0, const LAS unsigned char* Bimg, int b0, f32x4 acc, int lane) {
#pragma unroll
    for (int ks = 0; ks < 2; ++ks) {
        const bf16x8 af = ATR ? tr_frag(Aimg, 32 * ks, a0, lane) : row_frag(Aimg, 32 * ks, a0, lane);
        const bf16x8 bfr = BTR ? tr_frag(Bimg, 32 * ks, b0, lane) : row_frag(Bimg, 32 * ks, b0, lane);
        acc = __builtin_amdgcn_mfma_f32_16x16x32_bf16(af, bfr, acc, 0, 0, 0);
    }
    return acc;
}
__device__ __forceinline__ void st_T(LAS unsigned char* img, int r0, int c0, f32x4 v, int lane) {
    v2u w; w.x = pk2(v[0], v[1]); w.y = pk2(v[2], v[3]);
    *(LAS v2u*)(img + (c0 + (lane & 15)) * IMG_STRIDE + (r0 + 4 * (lane >> 4)) * 2) = w;
}
__device__ __forceinline__ f32x4 ld_T(const LAS unsigned char* img, int r0, int c0, int lane) {
    const v2u w = *(const LAS v2u*)(img + (c0 + (lane & 15)) * IMG_STRIDE + (r0 + 4 * (lane >> 4)) * 2);
    return (f32x4){bflo(w.x), bfhi(w.x), bflo(w.y), bfhi(w.y)};
}
__device__ __forceinline__ void st_T_g(bf16* slice, int r0, int c0, f32x4 v, int lane) {
    v2u w; w.x = pk2(v[0], v[1]); w.y = pk2(v[2], v[3]);
    st8_wt(slice + (size_t)(c0 + (lane & 15)) * 512 + r0 + 4 * (lane >> 4), w);
}
__device__ __forceinline__ void rwkv_pre_unit(Frame& F, int unit) {
    const int tid = F.tid, lane = F.lane, w = F.wave;
    const int c = unit >> 3, h = unit & 7;
    const size_t sl = (size_t)(64 * c) * 512 + 64 * h;
    const bf16* Rg = (const bf16*)(F.ws + WS_R) + sl; const bf16* LWg = (const bf16*)(F.ws + WS_EM1) + sl; const bf16* KHg = (const bf16*)(F.ws + WS_KH) + sl; const bf16* AAg = (const bf16*)(F.ws + WS_AA) + sl; const bf16* BBg = (const bf16*)(F.ws + WS_BB) + sl;
    bf16* PHIg = (bf16*)(F.ws + WS_PHI) + sl; bf16* GAMg = (bf16*)(F.ws + WS_GAM) + sl; bf16* PSIg = (bf16*)(F.ws + WS_PSI) + sl; bf16* OMEg = (bf16*)(F.ws + WS_OME) + sl;
    LAS unsigned char* L = F.lds;
#define IMG(k) (L + (k) * IMG_BYTES)
    LAS float* gt = (LAS float*)(L + 12 * IMG_BYTES);
    LAS float* WLs = gt + 8 * 64;
    {
        const bf16* Vg = (const bf16*)(F.ws + WS_V0) + sl; const bf16* Vg1 = (const bf16*)(F.ws + WS_V1) + sl;
        float ld[8], cum[8]; float run = 0.f;
#pragma unroll
        for (int q = 0; q < 8; ++q) { ld[q] = bf2f(LWg[(size_t)(8 * w + q) * 512 + lane]); run += ld[q]; cum[q] = run; }
        gt[w * 64 + lane] = run;
        __syncthreads();
        float pre = 0.f, tot = 0.f;
#pragma unroll
        for (int g2 = 0; g2 < 8; ++g2) { const float x = gt[g2 * 64 + lane]; tot += x; if (g2 < w) pre += x; }
        if (w == 0) WLs[lane] = __expf(tot);
#pragma unroll
        for (int q = 0; q < 8; ++q) {
            const int t = 8 * w + q; const size_t o = (size_t)t * 512 + lane;
            const float cu = pre + cum[q], cx = cu - ld[q];
            const float a = bf2f(AAg[o]), b = bf2f(BBg[o]), r = bf2f(Rg[o]), k = bf2f(KHg[o]);
            const float ein = __expf(-cu), eo = __expf(tot - cu);
            const int off = t * IMG_STRIDE + lane * 2;
            *(LAS unsigned short*)(IMG(0) + off) = (unsigned short)f2bf(a * __expf(cx));
            *(LAS unsigned short*)(IMG(1) + off) = (unsigned short)f2bf(r * __expf(cu));
            *(LAS unsigned short*)(IMG(2) + off) = (unsigned short)f2bf(b * ein);
            *(LAS unsigned short*)(IMG(3) + off) = (unsigned short)f2bf(k * ein);
            *(LAS unsigned short*)(IMG(4) + off) = (unsigned short)f2bf(b * eo);
            *(LAS unsigned short*)(IMG(5) + off) = (unsigned short)f2bf(k * eo);
            *(LAS unsigned short*)(IMG(6) + off) = F.vsel ? Vg1[o] : Vg[o];
        }
    }
    __syncthreads();
    const f32x4 zero4 = {0.f, 0.f, 0.f, 0.f};
    {
        const int mtx = w >> 1;
        const LAS unsigned char* Aimg = (mtx & 1) ? IMG(3) : IMG(2);
        const LAS unsigned char* Bimg = (mtx & 2) ? IMG(1) : IMG(0);
        LAS unsigned char* dst = IMG(7 + mtx);
        const bool incl = (mtx & 2) != 0;
#pragma unroll
        for (int q = 0; q < 8; ++q) {
            const int idx = 8 * (w & 1) + q, sr = idx >> 2, tc = idx & 3;
            f32x4 acc = zero4;
            if (sr <= tc) {
                acc = mm16<false, false>(Aimg, 16 * sr, Bimg, 16 * tc, acc, lane);
                if (sr == tc) {
#pragma unroll
                    for (int e = 0; e < 4; ++e) { const int s_ = 4 * (lane >> 4) + e, t_ = lane & 15; const bool keep = incl ? (s_ <= t_) : (s_ < t_); acc[e] = keep ? acc[e] : 0.f; }
                }
            }
            st_T(dst, 16 * sr, 16 * tc, acc, lane);
        }
    }
    __syncthreads();
    {
        const int t0 = 2 * w, t1 = 2 * w + 1;
#pragma unroll
        for (int q = 0; q < 2; ++q) {
            const int idx = q ? t1 : t0, sr = idx >> 2, tc = idx & 3;
            f32x4 acc = mm16<true, false>(IMG(7), 16 * sr, IMG(7), 16 * tc, zero4, lane);
            st_T(IMG(11), 16 * sr, 16 * tc, acc, lane);
            f32x4 tv = ld_T(IMG(7), 16 * sr, 16 * tc, lane);
#pragma unroll
            for (int e = 0; e < 4; ++e) tv[e] += (sr == tc && 4 * (lane >> 4) + e == (lane & 15)) ? 1.0f : 0.f;
            st_T(IMG(2), 16 * sr, 16 * tc, tv, lane);
        }
        __syncthreads();
#pragma unroll
        for (int it = 0; it < 4; ++it) {
            const LAS unsigned char* Pc = (it & 1) ? IMG(7) : IMG(11); LAS unsigned char* Pn = (it & 1) ? IMG(11) : IMG(7);
            const LAS unsigned char* Tc = (it & 1) ? IMG(3) : IMG(2);  LAS unsigned char* Tn = (it & 1) ? IMG(2) : IMG(3);
#pragma unroll
            for (int q = 0; q < 2; ++q) {
                const int idx = q ? t1 : t0, sr = idx >> 2, tc = idx & 3;
                f32x4 tv = ld_T(Tc, 16 * sr, 16 * tc, lane);
                tv = mm16<true, false>(Tc, 16 * sr, Pc, 16 * tc, tv, lane);
                st_T(Tn, 16 * sr, 16 * tc, tv, lane);
                f32x4 pv = mm16<true, false>(Pc, 16 * sr, Pc, 16 * tc, zero4, lane);
                st_T(Pn, 16 * sr, 16 * tc, pv, lane);
            }
            __syncthreads();
        }
#pragma unroll
        for (int q = 0; q < 2; ++q) {
            const int idx = q ? t1 : t0, sr = idx >> 2, tc = idx & 3;
            f32x4 tv = ld_T(IMG(2), 16 * sr, 16 * tc, lane);
            tv = mm16<true, false>(IMG(2), 16 * sr, IMG(11), 16 * tc, tv, lane);
            st_T(IMG(3), 16 * sr, 16 * tc, tv, lane);
        }
        __syncthreads();
#pragma unroll
        for (int q = 0; q < 2; ++q) {
            const int idx = q ? t1 : t0, sr = idx >> 2, tc = idx & 3;
            f32x4 xv = mm16<true, false>(IMG(0), 16 * sr, IMG(3), 16 * tc, zero4, lane);
            st_T(IMG(7), 16 * sr, 16 * tc, xv, lane);
            f32x4 wv = mm16<true, false>(IMG(8), 16 * sr, IMG(3), 16 * tc, zero4, lane);
            st_T(IMG(11), 16 * sr, 16 * tc, wv, lane);
        }
        __syncthreads();
#pragma unroll
        for (int q = 0; q < 2; ++q) {
            const int idx = q ? t1 : t0, sr = idx >> 2, tc = idx & 3;
            f32x4 zv = mm16<true, false>(IMG(6), 16 * sr, IMG(11), 16 * tc, zero4, lane);
            st_T(IMG(2), 16 * sr, 16 * tc, zv, lane);
            f32x4 ph = mm16<true, true>(IMG(7), 16 * sr, IMG(4), 16 * tc, zero4, lane);
            { const float wl = (sr == tc) ? WLs[16 * sr + (lane & 15)] : 0.f;
#pragma unroll
              for (int e = 0; e < 4; ++e) ph[e] += (4 * (lane >> 4) + e == (lane & 15)) ? wl : 0.f; }
            st_T(IMG(0), 16 * sr, 16 * tc, ph, lane);
            f32x4 ps = ld_T(IMG(1), 16 * sr, 16 * tc, lane);
            ps = mm16<true, false>(IMG(7), 16 * sr, IMG(9), 16 * tc, ps, lane);
            st_T(IMG(3), 16 * sr, 16 * tc, ps, lane);
        }
        __syncthreads();
#pragma unroll
        for (int q = 0; q < 2; ++q) {
            const int idx = q ? t1 : t0, sr = idx >> 2, tc = idx & 3;
            f32x4 ga = mm16<true, true>(IMG(4), 16 * sr, IMG(2), 16 * tc, zero4, lane);
            ga = mm16<true, true>(IMG(5), 16 * sr, IMG(6), 16 * tc, ga, lane);
            st_T(IMG(8), 16 * sr, 16 * tc, ga, lane);
            f32x4 om = mm16<false, true>(IMG(9), 16 * sr, IMG(2), 16 * tc, zero4, lane);
            om = mm16<false, true>(IMG(10), 16 * sr, IMG(6), 16 * tc, om, lane);
            st_T(IMG(11), 16 * sr, 16 * tc, om, lane);
        }
    }
    __syncthreads();
    { const int row = tid >> 3, pc = tid & 7; const size_t go = (size_t)row * 512 + pc * 8; const int lo = row * IMG_STRIDE + pc * 16;
      *(v4u*)(PHIg + go) = *(const LAS v4u*)(IMG(0) + lo); *(v4u*)(PSIg + go) = *(const LAS v4u*)(IMG(3) + lo);
      *(v4u*)(GAMg + go) = *(const LAS v4u*)(IMG(8) + lo); *(v4u*)(OMEg + go) = *(const LAS v4u*)(IMG(11) + lo); }
    __syncthreads();
#undef IMG
}
__device__ __forceinline__ void rwkv_scan_wave(Frame& F, int j, bool samp, int b, int h, int ih) {
    const int lane = F.lane, r32 = lane & 31, hi = lane >> 5;
    const int nch = samp ? 1 : ((F.nostate & 8) ? 2 : ((F.nostate & 16) ? 16 : 128));
    const int c0 = samp ? (256 + b) : (128 * b);
    const int i = 32 * ih + r32;
    const bf16* PH = (const bf16*)(F.ws + WS_PHI); const bf16* GA = (const bf16*)(F.ws + WS_GAM); bf16* SC = (bf16*)(F.ws + WS_SC);
    f32x16 s0, s1;
    if (samp) { const float* st = inp(F, I_SBW) + (((size_t)(j * 32 + b) * 8 + h) * 64 + i) * 64;
#pragma unroll
        for (int q4 = 0; q4 < 4; ++q4) { const f32x4 a = *(const f32x4*)(st + 8 * q4 + 4 * hi), c = *(const f32x4*)(st + 32 + 8 * q4 + 4 * hi);
            s0[4 * q4] = a.x; s0[4 * q4 + 1] = a.y; s0[4 * q4 + 2] = a.z; s0[4 * q4 + 3] = a.w; s1[4 * q4] = c.x; s1[4 * q4 + 1] = c.y; s1[4 * q4 + 2] = c.z; s1[4 * q4 + 3] = c.w; }
    } else {
#pragma unroll
        for (int r = 0; r < 16; ++r) { s0[r] = 0.f; s1[r] = 0.f; }
    }
    unsigned chk = 0u;
    v2u pfN[2][2][2][2]; v2u gfN[2][4];
#define SCAN_LOAD(CHUNK) do { const size_t sl_ = (size_t)(64 * (CHUNK)) * 512 + 64 * h; \
        _Pragma("unroll") for (int jbp = 0; jbp < 2; ++jbp) _Pragma("unroll") for (int jb = 0; jb < 2; ++jb) _Pragma("unroll") for (int s = 0; s < 2; ++s) { \
            const bf16* p_ = PH + sl_ + (size_t)(32 * jbp + r32) * 512 + 32 * jb + 16 * s + 4 * hi; pfN[jbp][jb][s][0] = ld8_sys(p_); pfN[jbp][jb][s][1] = ld8_sys(p_ + 8); } \
        _Pragma("unroll") for (int jbp = 0; jbp < 2; ++jbp) _Pragma("unroll") for (int q4 = 0; q4 < 4; ++q4) gfN[jbp][q4] = ld8_sys(GA + sl_ + (size_t)i * 512 + 32 * jbp + 8 * q4 + 4 * hi); } while (0)
    SCAN_LOAD(c0);
    for (int cc = 0; cc < nch; ++cc) {
        const size_t sl = (size_t)(64 * (c0 + cc)) * 512 + 64 * h;
        asm volatile("s_waitcnt vmcnt(0)" ::: "memory");
        __builtin_amdgcn_sched_barrier(0);
        v2u pf[2][2][2][2]; v2u gf[2][4];
#pragma unroll
        for (int jbp = 0; jbp < 2; ++jbp) {
#pragma unroll
            for (int jb = 0; jb < 2; ++jb)
#pragma unroll
                for (int s = 0; s < 2; ++s) { pf[jbp][jb][s][0] = pfN[jbp][jb][s][0]; pf[jbp][jb][s][1] = pfN[jbp][jb][s][1]; }
#pragma unroll
            for (int q4 = 0; q4 < 4; ++q4) gf[jbp][q4] = gfN[jbp][q4];
        }
        if (F.nostate & 1) {
#pragma unroll
            for (int jbp = 0; jbp < 2; ++jbp) {
#pragma unroll
                for (int jb = 0; jb < 2; ++jb)
#pragma unroll
                    for (int s = 0; s < 2; ++s) chk += pf[jbp][jb][s][0].x * 3u + pf[jbp][jb][s][0].y * 5u + pf[jbp][jb][s][1].x * 7u + pf[jbp][jb][s][1].y * 11u;
#pragma unroll
                for (int q4 = 0; q4 < 4; ++q4) chk += gf[jbp][q4].x * 13u + gf[jbp][q4].y * 17u;
            }
            chk = chk * 31u + (unsigned)cc;
        }
        bf16x8 bfr[2][2];
#pragma unroll
        for (int jb = 0; jb < 2; ++jb) {
            const f32x16& sv = jb ? s1 : s0;
            v4u lo, hi4; lo.x = pk2(sv[0], sv[1]); lo.y = pk2(sv[2], sv[3]); lo.z = pk2(sv[4], sv[5]); lo.w = pk2(sv[6], sv[7]);
            hi4.x = pk2(sv[8], sv[9]); hi4.y = pk2(sv[10], sv[11]); hi4.z = pk2(sv[12], sv[13]); hi4.w = pk2(sv[14], sv[15]);
            bfr[jb][0] = __builtin_bit_cast(bf16x8, lo); bfr[jb][1] = __builtin_bit_cast(bf16x8, hi4);
            bf16* sp = SC + sl + (size_t)i * 512 + 32 * jb + 4 * hi;
            v2u t0; t0.x = lo.x; t0.y = lo.y; st8_wt(sp, t0); t0.x = lo.z; t0.y = lo.w; st8_wt(sp + 8, t0);
            t0.x = hi4.x; t0.y = hi4.y; st8_wt(sp + 16, t0); t0.x = hi4.z; t0.y = hi4.w; st8_wt(sp + 24, t0);
        }
        __builtin_amdgcn_sched_barrier(0);
        { const int cn = (cc + 1 < nch) ? (c0 + cc + 1) : (c0 + cc); SCAN_LOAD(cn); }
        __builtin_amdgcn_sched_barrier(0);
        f32x16 n0, n1;
#pragma unroll
        for (int q4 = 0; q4 < 4; ++q4) {
            n0[4 * q4] = bflo(gf[0][q4].x); n0[4 * q4 + 1] = bfhi(gf[0][q4].x); n0[4 * q4 + 2] = bflo(gf[0][q4].y); n0[4 * q4 + 3] = bfhi(gf[0][q4].y);
            n1[4 * q4] = bflo(gf[1][q4].x); n1[4 * q4 + 1] = bfhi(gf[1][q4].x); n1[4 * q4 + 2] = bflo(gf[1][q4].y); n1[4 * q4 + 3] = bfhi(gf[1][q4].y);
        }
#pragma unroll
        for (int jb = 0; jb < 2; ++jb)
#pragma unroll
            for (int s = 0; s < 2; ++s) {
                v4u a0; a0.x = pf[0][jb][s][0].x; a0.y = pf[0][jb][s][0].y; a0.z = pf[0][jb][s][1].x; a0.w = pf[0][jb][s][1].y;
                v4u a1; a1.x = pf[1][jb][s][0].x; a1.y = pf[1][jb][s][0].y; a1.z = pf[1][jb][s][1].x; a1.w = pf[1][jb][s][1].y;
                n0 = __builtin_amdgcn_mfma_f32_32x32x16_bf16(__builtin_bit_cast(bf16x8, a0), bfr[jb][s], n0, 0, 0, 0);
                n1 = __builtin_amdgcn_mfma_f32_32x32x16_bf16(__builtin_bit_cast(bf16x8, a1), bfr[jb][s], n1, 0, 0, 0);
            }
        s0 = n0; s1 = n1;
        asm volatile("s_nop 15\n\ts_nop 15" : "+v"(s0), "+v"(s1));
        __builtin_amdgcn_sched_barrier(0);
    }
    asm volatile("s_waitcnt vmcnt(0)" ::: "memory");
#undef SCAN_LOAD
    if (F.nostate & 1) { if (!samp) ((unsigned*)(F.ws + WS_END))[(size_t)(((b * 8 + h) * 2 + ih) * 64 + lane)] = chk; return; }
    float* so = (float*)F.out + (samp ? O_SBW : O_PBW) + (((size_t)(j * (samp ? 32 : 2) + b) * 8 + h) * 64 + i) * 64;
#pragma unroll
    for (int q4 = 0; q4 < 4; ++q4) {
        *(f32x4*)(so + 8 * q4 + 4 * hi) = (f32x4){s0[4 * q4], s0[4 * q4 + 1], s0[4 * q4 + 2], s0[4 * q4 + 3]};
        *(f32x4*)(so + 32 + 8 * q4 + 4 * hi) = (f32x4){s1[4 * q4], s1[4 * q4 + 1], s1[4 * q4 + 2], s1[4 * q4 + 3]};
    }
}
__device__ __forceinline__ void phase_scan(Frame& F, int j) {
    const int gw = F.bid * NWAVES + F.wave;
    if (F.wave == 0) { if (F.bid < 32 && !(F.nostate & 2)) rwkv_scan_wave(F, j, false, F.bid >> 4, (F.bid >> 1) & 7, F.bid & 1); }
    else { const int u = F.bid * 7 + (F.wave - 1); if (u < 512 && !(F.nostate & 4)) rwkv_scan_wave(F, j, true, u >> 4, (u >> 1) & 7, u & 1); }
    (void)gw;
    if ((F.nostate & 1) && F.bid >= 128) {
        const unsigned* a = (const unsigned*)(F.ws + WS_PHI); unsigned c1 = 0u;
        const size_t nw = (size_t)M * 512 / 2 * 2;
        for (size_t i = (size_t)(F.bid - 128) * NTHR + F.tid; i < nw; i += (size_t)128 * NTHR) c1 += __hip_atomic_load(a + i, __ATOMIC_RELAXED, __HIP_MEMORY_SCOPE_SYSTEM) * (unsigned)(2 * (i & 1023) + 1);
        ((unsigned*)(F.ws + WS_END))[4096 + (size_t)(F.bid - 128) * NTHR + F.tid] = c1;
    }
}
__device__ __forceinline__ void rwkv_out_unit(Frame& F, int j, int c) {
    const int lane = F.lane, h = F.wave;
    const size_t sl = (size_t)(64 * c) * 512 + 64 * h;
    const bf16* PS = (const bf16*)(F.ws + WS_PSI) + sl; const bf16* OM = (const bf16*)(F.ws + WS_OME) + sl; const bf16* SC = (const bf16*)(F.ws + WS_SC) + sl;
    const bf16* V = (const bf16*)(F.ws + (j == 0 ? WS_V0 : WS_V1)) + sl; const float* BON = (const float*)(F.ws + WS_BONUS);
    bf16* MIX = (bf16*)(F.ws + WS_MIX);
    const int fr = lane & 15, fq = lane >> 4;
    bf16x8 af[4][2], bfm[4][2];
#pragma unroll
    for (int q = 0; q < 4; ++q)
#pragma unroll
        for (int ks = 0; ks < 2; ++ks) { af[q][ks] = ld16_sys(PS + (size_t)(16 * q + fr) * 512 + 32 * ks + 8 * fq); bfm[q][ks] = ld16_sys(SC + (size_t)(16 * q + fr) * 512 + 32 * ks + 8 * fq); }
    const float lw[4] = {inp(F, I_LNXW)[j * 512 + 64 * h + fr], inp(F, I_LNXW)[j * 512 + 64 * h + 16 + fr], inp(F, I_LNXW)[j * 512 + 64 * h + 32 + fr], inp(F, I_LNXW)[j * 512 + 64 * h + 48 + fr]};
    const float lb[4] = {inp(F, I_LNXB)[j * 512 + 64 * h + fr], inp(F, I_LNXB)[j * 512 + 64 * h + 16 + fr], inp(F, I_LNXB)[j * 512 + 64 * h + 32 + fr], inp(F, I_LNXB)[j * 512 + 64 * h + 48 + fr]};
#pragma unroll
    for (int tr = 0; tr < 4; ++tr) {
        f32x4 y[4];
#pragma unroll
        for (int ic = 0; ic < 4; ++ic) {
            const v2u ow = ld8_sys(OM + (size_t)(16 * ic + fr) * 512 + 16 * tr + 4 * fq);
            f32x4 acc = {bflo(ow.x), bfhi(ow.x), bflo(ow.y), bfhi(ow.y)};
            acc = __builtin_amdgcn_mfma_f32_16x16x32_bf16(af[tr][0], bfm[ic][0], acc, 0, 0, 0);
            acc = __builtin_amdgcn_mfma_f32_16x16x32_bf16(af[tr][1], bfm[ic][1], acc, 0, 0, 0);
            y[ic] = acc;
        }
#pragma unroll
        for (int e = 0; e < 4; ++e) {
            float sm = (y[0][e] + y[1][e]) + (y[2][e] + y[3][e]);
            sm += __shfl_xor(sm, 1); sm += __shfl_xor(sm, 2); sm += __shfl_xor(sm, 4); sm += __shfl_xor(sm, 8);
            const float mean = sm * (1.0f / 64.0f);
            const float d0 = y[0][e] - mean, d1 = y[1][e] - mean, d2 = y[2][e] - mean, d3 = y[3][e] - mean;
            float q = (d0 * d0 + d1 * d1) + (d2 * d2 + d3 * d3);
            q += __shfl_xor(q, 1); q += __shfl_xor(q, 2); q += __shfl_xor(q, 4); q += __shfl_xor(q, 8);
            const float rstd = 1.0f / sqrtf(q * (1.0f / 64.0f) + 64e-5f);
            const int row = 64 * c + 16 * tr + 4 * fq + e;
            const float bon = BON[(size_t)row * 8 + h];
            const float dd[4] = {d0, d1, d2, d3};
#pragma unroll
            for (int ic = 0; ic < 4; ++ic) {
                const int ch = 16 * ic + fr;
                const float v = bf2f(V[(size_t)(16 * tr + 4 * fq + e) * 512 + ch]);
                bf16* mp = MIX + (size_t)row * D + 512 + 64 * h + ch;
                const float g = bf2f(*mp);
                *mp = (bf16)f2bf((dd[ic] * rstd * lw[ic] + lb[ic] + bon * v) * g);
            }
        }
    }
}
__device__ __forceinline__ void phase_post(Frame& F, int j) { for (int c = F.bid; c < NCHUNK; c += F.G) rwkv_out_unit(F, j, c); }
__device__ __forceinline__ void phase_final(Frame& F) {
    const GAS float* ss2 = (const GAS float*)(F.ws + WS_SS2); const float* gf = inp(F, I_NFIN);
    const int gw = F.bid * NWAVES + F.wave, NGW = F.G * NWAVES;
    for (int m = gw; m < M; m += NGW) {
        const float sc = 1.0f / sqrtf(row_ss(ss2, m) * (1.0f / 1024.0f) + RMS_EPS);
        GAS f32x4* xo = (GAS f32x4*)(F.out + (size_t)m * D) + F.lane;
#pragma unroll
        for (int q = 0; q < 4; ++q) { f32x4 v = xo[64 * q]; const f32x4 g = *((const GAS f32x4*)gf + F.lane + 64 * q); v = v * sc * g; xo[64 * q] = v; }
    }
}

constexpr int N_PHASES = 34;
#ifndef MK_DUP
#define MK_DUP 0ull
#endif
#ifndef MK_SKIP
#define MK_SKIP 0ull
#endif
#ifndef MK_LAST
#define MK_LAST N_PHASES
#endif
#ifndef MK_PER_PHASE
#define MK_PER_PHASE 0
#endif
#ifndef MK_NOSTATE
#define MK_NOSTATE 0
#endif
#ifndef MK_DUMPSEL
#define MK_DUMPSEL 0
#endif
#ifndef PH_MASK
#define PH_MASK 0xFFFF
#endif
__host__ __device__ inline bool phase_exists(int p) { if (p == 0 || p == N_PHASES - 1) return true; const int L = (p - 1) / 8, s = (p - 1) % 8; return !((L & 1) && (s >= 2 && s <= 4)); }

__global__ void __launch_bounds__(NTHR, 2) mk_fwd(Args args) {
    extern __shared__ __attribute__((aligned(16))) unsigned char lds_raw[];
    Frame F;
    F.lds = (LAS unsigned char*)lds_raw;
    F.tid = threadIdx.x; F.lane = F.tid & 63; F.wave = __builtin_amdgcn_readfirstlane(F.tid >> 6);
    F.G = gridDim.x; F.bid = blockIdx.x; F.out = (GAS float*)args.out; F.ws = (GAS unsigned char*)args.ws;
    volatile LAS unsigned* MISC = (volatile LAS unsigned*)(F.lds + MISC_OFF);
    for (int u = F.tid; u < (LDS_BYTES - LDSCTL_OFF) / 4; u += NTHR) ((LAS unsigned*)(F.lds + LDSCTL_OFF))[u] = 0u;
    __syncthreads();
    XcdBarrier bar; bar.bar = (unsigned*)(F.ws + WS_CTL) + 4096; bar.x = 0; bar.st = nullptr;
    if (args.use_bar) bar = xcd_barrier_post((unsigned*)(F.ws + WS_CTL) + 4096, MISC + 8);
    bool first = true;
    for (int p = args.ph_lo; p < args.ph_hi; ++p) {
        if (!phase_exists(p)) continue;
      for (int rep = 0; rep < (((MK_DUP >> p) & 1ull) ? 2 : 1); ++rep) {
        if (!first) xcd_barrier(bar);
        first = false;
        { int t_ = threadIdx.x; asm volatile("" : "+v"(t_)); F.tid = t_; F.lane = t_ & 63; F.wave = __builtin_amdgcn_readfirstlane(t_ >> 6); unsigned char* ws_ = args.ws; float* out_ = args.out; F.G = gridDim.x; F.bid = blockIdx.x; asm volatile("" : "+s"(ws_), "+s"(out_), "+s"(F.G), "+s"(F.bid)); F.ws = (GAS unsigned char*)ws_; F.out = (GAS float*)out_; }
        if (p == 0) { if constexpr (PH_MASK & 1) phase_prologue(F); continue; }
        if (p == N_PHASES - 1) { if constexpr (PH_MASK & 256) phase_final(F); continue; }
        const int L = (p - 1) / 8, s = (p - 1) % 8, j = L >> 1, odd = L & 1; F.vsel = j; F.nostate = (args.use_bar >> 1) & 31;
        unsigned char* wl = (unsigned char*)(F.ws + WS_W + (size_t)L * WL_STRIDE);
        bf16* XB = (bf16*)(F.ws + WS_XB); bf16* P = (bf16*)(F.ws + WS_P); bf16* MIX = (bf16*)(F.ws + WS_MIX); bf16* H = (bf16*)(F.ws + WS_H);
        float* ss1 = (float*)(F.ws + WS_SS1); float* ss2 = (float*)(F.ws + WS_SS2);
        if (s == 0) {
            pg8::Gemm g{XB, (const bf16*)(wl + W1_OFF), M, NPROJ, D}; pg8::StaticOrder S; S.init(M, NPROJ, F.G, F.bid);
            pg8::EpiProj E{F.ws};
            if constexpr (PH_MASK & 2) pg8::gemm_phase<pg8::EpiProj, pg8::StaticOrder, true, true>(F.lds, g, S, E);
        } else if (s == 1) {
            if constexpr (PH_MASK & 2048) side_outputs(F, j, odd);
            if (odd) { for (int it = F.bid; it < 1152; it += F.G) { if (it < 576) { if constexpr (PH_MASK & 8) attn_unit<true>(F, j, it); } else { if constexpr (PH_MASK & 1024) conv_unit(F, j, it - 576); } } }
            else { for (int it = F.bid; it < 576 + M / B1_T; it += F.G) { if (it < 576) { if constexpr (PH_MASK & 4) attn_unit<false>(F, j, it); } else { if constexpr (PH_MASK & 512) rwkv_b1_unit(F, j, it - 576); } } }
        } else if (s == 2) { if constexpr (PH_MASK & 4096) { for (int it = F.bid; it < NCHUNK * 8; it += F.G) rwkv_pre_unit(F, it); }
        } else if (s == 3) { if constexpr (PH_MASK & 16) phase_scan(F, j);
        } else if (s == 4) { if constexpr (PH_MASK & 32) phase_post(F, j);
        } else if (s == 5) {
            pg8::Gemm g{MIX, (const bf16*)(wl + W2_OFF), M, D, D}; pg8::StaticOrder S; S.init(M, D, F.G, F.bid);
            pg8::EpiResid E{F.out, F.ws, WS_SS1};
            if constexpr (PH_MASK & 64) pg8::gemm_phase<pg8::EpiResid, pg8::StaticOrder, true, true>(F.lds, g, S, E);
        } else if (s == 6) {
            pg8::Gemm g{XB, (const bf16*)(wl + W3_OFF), M, NGU, D}; pg8::StaticOrder S; S.init(M, NGU, F.G, F.bid);
            pg8::EpiSwiglu E{F.ws};
            if constexpr (PH_MASK & 128) pg8::gemm_phase<pg8::EpiSwiglu, pg8::StaticOrder, true, true>(F.lds, g, S, E);
        } else {
            pg8::Gemm g{H, (const bf16*)(wl + W4_OFF), M, D, DFF}; pg8::StaticOrder S; S.init(M, D, F.G, F.bid);
            pg8::EpiResid E{F.out, F.ws, WS_SS2};
            if constexpr (PH_MASK & 64) pg8::gemm_phase<pg8::EpiResid, pg8::StaticOrder, true, true>(F.lds, g, S, E);
        }
      }
    }    if (args.pad != 0) {
        xcd_barrier(bar);
        const int sel = args.pad;
        const size_t offs[15] = {0, WS_R, WS_EM1, WS_KH, WS_AA, WS_BB, WS_V0, WS_MIX, WS_PHI, WS_GAM, WS_PSI, WS_OME, WS_SC, WS_BONUS, WS_P};
        const GAS bf16* src = (const GAS bf16*)((GAS unsigned char*)args.ws + offs[sel <= 14 ? sel : 0]); (void)src; GAS float* dst = (GAS float*)args.out;
        const size_t n = (sel == 13) ? (size_t)M * 4 : (size_t)M * 512;
        if (sel >= 20) {
            const size_t nwords = (sel - 20 == 14) ? (size_t)M * NPROJ / 2 : ((sel - 20 == 7) ? (size_t)M * D / 2 : (size_t)M * 256);
            const GAS unsigned* a = (const GAS unsigned*)((GAS unsigned char*)args.ws + offs[sel - 20]);
            const size_t me = (size_t)blockIdx.x * NTHR + threadIdx.x; unsigned c1 = 0u;
            for (size_t i = me; i < nwords; i += (size_t)gridDim.x * NTHR) c1 = c1 * 1664525u + a[i];
            dst[2 * me] = (float)(c1 & 0xffffu); dst[2 * me + 1] = (float)(c1 >> 16);
        }
        else if (sel == 18) { const GAS unsigned* cs = (const GAS unsigned*)((GAS unsigned char*)args.ws + WS_END) + 4096;
            for (size_t i = (size_t)blockIdx.x * NTHR + threadIdx.x; i < 65536; i += (size_t)gridDim.x * NTHR) { dst[2 * i] = (float)(cs[i] & 0xffffu); dst[2 * i + 1] = (float)(cs[i] >> 16); } }
        else if (sel == 17) { const GAS unsigned* cs = (const GAS unsigned*)((GAS unsigned char*)args.ws + WS_END);
            for (size_t i = (size_t)blockIdx.x * NTHR + threadIdx.x; i < 2048; i += (size_t)gridDim.x * NTHR) { dst[2 * i] = (float)(cs[i] & 0xffffu); dst[2 * i + 1] = (float)(cs[i] >> 16); } }
        else if (sel <= 14) { for (size_t i = (size_t)blockIdx.x * NTHR + threadIdx.x; i < n; i += (size_t)gridDim.x * NTHR) dst[i] = bf2f(src[i]); }
        else { const int lo = (sel == 15) ? 1 : 8, hi = (sel == 15) ? 6 : 11;
            for (size_t i = (size_t)blockIdx.x * NTHR + threadIdx.x; i < (size_t)M * 512; i += (size_t)gridDim.x * NTHR) { float a = 0.f;
                for (int k = lo; k <= hi; ++k) a += bf2f(((const GAS bf16*)((GAS unsigned char*)args.ws + offs[k]))[i]); dst[i] = a; } }
    }
}

extern "C" void kernel_launch(void* const* d_in, const int* in_sizes, int n_in, void* d_out, int out_size, void* d_ws, size_t ws_size, hipStream_t stream) {
    static int grid = 0;
    if (grid == 0) {
        if (n_in != N_IN || out_size != (int)O_END || ws_size < WS_END) { fprintf(stderr, "kernel_launch: unexpected shapes (n_in %d out %d ws %zu)\n", n_in, out_size, ws_size); grid = -1; return; }
        int dev = 0, cus = 0;
        if (hipGetDevice(&dev) != hipSuccess || hipDeviceGetAttribute(&cus, hipDeviceAttributeMultiprocessorCount, dev) != hipSuccess) { grid = -1; return; }
        if (hipFuncSetAttribute((const void*)mk_fwd, hipFuncAttributeMaxDynamicSharedMemorySize, LDS_BYTES) != hipSuccess) { fprintf(stderr, "kernel_launch: hipFuncSetAttribute failed\n"); grid = -1; return; }
        int per_cu = 0;
        if (hipOccupancyMaxActiveBlocksPerMultiprocessor(&per_cu, (const void*)mk_fwd, NTHR, LDS_BYTES) != hipSuccess || per_cu < 1) fprintf(stderr, "kernel_launch: occupancy query says %d\n", per_cu);
        (void)hipGetLastError();
        grid = cus;
    }
    if (grid < 0) return;
    (void)hipMemsetAsync((char*)d_ws + WS_CTL, 0, CTL_ZERO_BYTES, stream);
    Args a{};
    for (int i = 0; i < N_IN; ++i) a.in[i] = (const float*)d_in[i];
    a.out = (float*)d_out; a.ws = (unsigned char*)d_ws;
#if MK_PER_PHASE
    for (int p = 0; p < MK_LAST; ++p) { if (!phase_exists(p) || ((MK_SKIP >> p) & 1ull)) continue; a.ph_lo = p; a.ph_hi = p + 1; a.use_bar = 0; hipLaunchKernelGGL(mk_fwd, dim3(grid), dim3(NTHR), LDS_BYTES, stream, a); }
#else
    a.ph_lo = 0; a.ph_hi = MK_LAST; a.use_bar = 1 | (MK_NOSTATE << 1); a.pad = MK_DUMPSEL;
    hipLaunchKernelGGL(mk_fwd, dim3(grid), dim3(NTHR), LDS_BYTES, stream, a);
#endif
}
```

```cpp
#include <hip/hip_runtime.h>
#include <cstdio>
#include <cstdint>
namespace pg8 {
#define PG8_LAS __attribute__((address_space(3)))
typedef unsigned short bf16_t;
typedef short bf16x8 __attribute__((ext_vector_type(8)));
typedef float f32x4 __attribute__((ext_vector_type(4)));
typedef unsigned u32x4 __attribute__((ext_vector_type(4)));
constexpr int BM = 256, BK = 64, HALF = 128, HTB = HALF * BK * 2  , STAGE_BYTES = 8 * HTB, NXCD = 8, WGM = 8;

__host__ __device__ __forceinline__ int lds_byte(int r, int c) { const int st = (r >> 4) * 2 + (c >> 5), rr = r & 15, cc = c & 31, ob = rr * 64 + cc * 2; return st * 1024 + (ob ^ (((ob >> 9) & 1) << 5)); }
__host__ __device__ __forceinline__ void stage_rc(int b, int& R, int& C) { const int st = b / 1024, sb = b % 1024, swz = sb ^ (((sb >> 9) & 1) << 5); R = (st >> 1) * 16 + swz / 64; C = (st & 1) * 32 + (swz % 64) / 2; }
__host__ __device__ __forceinline__ int perm32(int rho) { const int n = rho >> 4, i = rho & 15; return 8 * (i >> 2) + 4 * n + (i & 3); }

struct Unit { int pm, pn; };
struct Gemm { const bf16_t* A; const bf16_t* Bt; int M, N, K; };

struct StaticOrder {
    int nM, nN, nwg, G, c;
    __host__ __device__ void init(int M, int N, int G_, int c_) { nM = M / BM; nN = N / BM; nwg = nM * nN; G = G_; c = c_; }
    __host__ __device__ bool next(int i, Unit& u) const {
        const long L = (long)i * G + c; if (L >= nwg) return false;
        int wgid = (int)L; { const int q = nwg / NXCD, r = nwg % NXCD, xcd = wgid % NXCD, off = wgid / NXCD; wgid = (xcd < r ? xcd * (q + 1) : r * (q + 1) + (xcd - r) * q) + off; }
        const int nig = WGM * nN, gid = wgid / nig, fm = gid * WGM, gsz = (nM - fm) < WGM ? (nM - fm) : WGM;
        u.pm = fm + ((wgid % nig) % gsz); u.pn = (wgid % nig) / gsz; return true;
    }
    __device__ __forceinline__ void a_ready(const Unit&) const {}
    __device__ __forceinline__ void done(const Unit&) const {}
};

typedef float f32x2_t __attribute__((ext_vector_type(2))); typedef __bf16 bf16x2_t __attribute__((ext_vector_type(2)));
__device__ __forceinline__ unsigned cvt_pk_bf16(float lo, float hi) { f32x2_t v = {lo, hi}; bf16x2_t b = __builtin_convertvector(v, bf16x2_t); return __builtin_bit_cast(unsigned, b); }

template <class Epi, class Sched, bool ALIGN_EPI = false, bool SP2 = false>
__device__ __forceinline__ void gemm_phase(PG8_LAS unsigned char* lds, const Gemm g, const Sched& S, const Epi& E) {
    int tid_ = threadIdx.x; asm volatile("" : "+v"(tid_));
    const int tid = tid_, wid = __builtin_amdgcn_readfirstlane(tid >> 6), lane = tid & 63, wr = wid >> 2, wc = wid & 3, fr = lane & 15, fq = lane >> 4;
    const int K = g.K, nt = K / BK;
    unsigned voffA[2], voffB[2];
#pragma unroll
    for (int i = 0; i < 2; ++i) { int R, C; stage_rc(tid * 16 + i * 8192, R, C); const int Rb = Epi::PERM ? ((R & ~31) + perm32(R & 31)) : R;
        voffA[i] = (unsigned)(R * K + C) * 2u; voffB[i] = (unsigned)(Rb * K + C) * 2u; }
    const size_t kstep = (size_t)(BK * 2);
    const size_t hstep = (size_t)HALF * K * 2;
    const size_t tstep = 2 * hstep;
    const unsigned ldsw = (unsigned)wid * 1024u;
    const int aoff = lds_byte(wr * 64 + fr, fq * 8), boff = lds_byte(wc * 32 + fr, fq * 8);
#define PG8_SA(b, h) (((b) * 2 + (h)) * HTB)
#define PG8_SB(b, h) ((4 + (b) * 2 + (h)) * HTB)
#define PG8_STAGE(bufoff, gbase, voff) do { _Pragma("unroll") for (int _i = 0; _i < 2; ++_i) \
        __builtin_amdgcn_global_load_lds((const unsigned*)((const char*)(gbase) + (voff)[_i]), (PG8_LAS unsigned*)(lds + (bufoff) + ldsw + _i * 8192), 16, 0, 0); } while (0)
#define PG8_LDA(dst, b, h) do { _Pragma("unroll") for (int m = 0; m < 4; ++m) _Pragma("unroll") for (int k = 0; k < 2; ++k) dst[m][k] = *(const PG8_LAS bf16x8*)(lds + PG8_SA(b, h) + aoff + m * 2048 + k * 1024); } while (0)
#define PG8_LDB(dst, b, h) do { _Pragma("unroll") for (int n = 0; n < 2; ++n) _Pragma("unroll") for (int k = 0; k < 2; ++k) dst[n][k] = *(const PG8_LAS bf16x8*)(lds + PG8_SB(b, h) + boff + n * 2048 + k * 1024); } while (0)
#define PG8_MMA(ai, bj, At, Bt) do { __builtin_amdgcn_s_setprio(1); _Pragma("unroll") for (int m = 0; m < 4; ++m) _Pragma("unroll") for (int n = 0; n < 2; ++n) _Pragma("unroll") for (int k = 0; k < 2; ++k) \
        acc[ai][bj][m][n] = __builtin_amdgcn_mfma_f32_16x16x32_bf16(Bt[n][k], At[m][k], acc[ai][bj][m][n], 0, 0, 0); __builtin_amdgcn_s_setprio(0); } while (0)
#define PG8_WAIT_V(n) asm volatile("s_waitcnt vmcnt(" #n ")" ::: "memory")
#define PG8_WAIT_L(n) asm volatile("s_waitcnt lgkmcnt(" #n ")" ::: "memory")
#define PG8_BAR __builtin_amdgcn_s_barrier()
#define PG8_SCHED __builtin_amdgcn_sched_barrier(0)
    Unit cur, nxt; int ui = 0;
    if (!S.next(0, cur)) return;
    f32x4 acc[2][2][4][2];
#pragma unroll
    for (int a = 0; a < 2; ++a)
#pragma unroll
        for (int b = 0; b < 2; ++b)
#pragma unroll
            for (int m = 0; m < 4; ++m)
#pragma unroll
                for (int n = 0; n < 2; ++n) acc[a][b][m][n] = (f32x4){0.f, 0.f, 0.f, 0.f};
    bf16x8 At[4][2], B0[2][2], B1[2][2];
    const char* cA = (const char*)g.A + (size_t)cur.pm * tstep; const char* cB = (const char*)g.Bt + (size_t)cur.pn * tstep;
    S.a_ready(cur);
    if constexpr (SP2) {
        PG8_STAGE(PG8_SB(0, 0), cB, voffB); PG8_STAGE(PG8_SB(0, 1), cB + hstep, voffB); PG8_STAGE(PG8_SA(0, 0), cA, voffA); PG8_STAGE(PG8_SA(0, 1), cA + hstep, voffA);
        if (wr == 1) PG8_BAR;
        PG8_WAIT_V(2); PG8_BAR;
        PG8_STAGE(PG8_SB(1, 0), cB + kstep, voffB); PG8_STAGE(PG8_SA(1, 0), cA + kstep, voffA); PG8_STAGE(PG8_SB(1, 1), cB + hstep + kstep, voffB);
        PG8_WAIT_V(6); PG8_BAR;
    } else {
        PG8_STAGE(PG8_SB(0, 0), cB, voffB); PG8_STAGE(PG8_SA(0, 0), cA, voffA); PG8_STAGE(PG8_SB(0, 1), cB + hstep, voffB); PG8_STAGE(PG8_SA(0, 1), cA + hstep, voffA);
        if (wr == 1) PG8_BAR;
        PG8_WAIT_V(4); PG8_BAR;
        PG8_STAGE(PG8_SB(1, 0), cB + kstep, voffB); PG8_STAGE(PG8_SA(1, 0), cA + kstep, voffA); PG8_STAGE(PG8_SB(1, 1), cB + hstep + kstep, voffB);
        PG8_WAIT_V(6); PG8_BAR;
    }
    for (;;) {
        const bool has_next = S.next(ui + 1, nxt);
        const char* nA = has_next ? (const char*)g.A + (size_t)nxt.pm * tstep : cA; const char* nB = has_next ? (const char*)g.Bt + (size_t)nxt.pn * tstep : cB;
        for (int t = 0; t < nt; t += 2) {
            const bool last = (t == nt - 2);
            const char* a1 = cA + (size_t)(t + 1) * kstep;
            const char* a2 = last ? nA : cA + (size_t)(t + 2) * kstep; const char* b2 = last ? nB : cB + (size_t)(t + 2) * kstep;
            const char* a3 = a2 + kstep; const char* b3 = b2 + kstep;
            if (last && has_next) S.a_ready(nxt);
            if constexpr (SP2) {
            PG8_LDB(B0, 0, 0); PG8_LDB(B1, 0, 1); PG8_SCHED; PG8_LDA(At, 0, 0); PG8_STAGE(PG8_SA(1, 1), a1 + hstep, voffA);
            PG8_WAIT_V(8); PG8_WAIT_L(0); PG8_BAR; PG8_MMA(0, 0, At, B0); PG8_MMA(0, 1, At, B1); PG8_BAR; PG8_SCHED;
            PG8_LDA(At, 0, 1); PG8_STAGE(PG8_SB(0, 0), b2, voffB); PG8_STAGE(PG8_SB(0, 1), b2 + hstep, voffB); PG8_STAGE(PG8_SA(0, 0), a2, voffA);
            PG8_WAIT_V(8); PG8_WAIT_L(0); PG8_BAR; PG8_MMA(1, 0, At, B0); PG8_MMA(1, 1, At, B1); PG8_BAR; PG8_SCHED;
            PG8_LDB(B0, 1, 0); PG8_LDB(B1, 1, 1); PG8_SCHED; PG8_LDA(At, 1, 0); PG8_STAGE(PG8_SA(0, 1), a2 + hstep, voffA);
            PG8_WAIT_V(8); PG8_WAIT_L(0); PG8_BAR; PG8_MMA(0, 0, At, B0); PG8_MMA(0, 1, At, B1); PG8_BAR; PG8_SCHED;
            PG8_LDA(At, 1, 1); PG8_STAGE(PG8_SB(1, 0), b3, voffB); PG8_STAGE(PG8_SB(1, 1), b3 + hstep, voffB); PG8_STAGE(PG8_SA(1, 0), a3, voffA);
            PG8_WAIT_V(8); PG8_WAIT_L(0); PG8_BAR; PG8_MMA(1, 0, At, B0); PG8_MMA(1, 1, At, B1); PG8_BAR; PG8_SCHED;
            } else {
            PG8_LDB(B0, 0, 0); PG8_SCHED; PG8_LDA(At, 0, 0); PG8_STAGE(PG8_SA(1, 1), a1 + hstep, voffA);
            PG8_WAIT_L(8); PG8_BAR; PG8_WAIT_L(0); PG8_MMA(0, 0, At, B0); PG8_BAR; PG8_SCHED;
            PG8_LDB(B1, 0, 1); PG8_STAGE(PG8_SB(0, 0), b2, voffB);
            PG8_BAR; PG8_WAIT_L(0); PG8_MMA(0, 1, At, B1); PG8_BAR;
            PG8_LDA(At, 0, 1); PG8_STAGE(PG8_SA(0, 0), a2, voffA);
            PG8_BAR; PG8_WAIT_L(0); PG8_MMA(1, 0, At, B0); PG8_BAR; PG8_SCHED;
            PG8_STAGE(PG8_SB(0, 1), b2 + hstep, voffB);
            PG8_WAIT_V(6); PG8_BAR; PG8_MMA(1, 1, At, B1); PG8_BAR;
            PG8_LDB(B0, 1, 0); PG8_SCHED; PG8_LDA(At, 1, 0); PG8_STAGE(PG8_SA(0, 1), a2 + hstep, voffA);
            PG8_WAIT_L(8); PG8_BAR; PG8_WAIT_L(0); PG8_MMA(0, 0, At, B0); PG8_BAR; PG8_SCHED;
            PG8_LDB(B1, 1, 1); PG8_STAGE(PG8_SB(1, 0), b3, voffB);
            PG8_BAR; PG8_WAIT_L(0); PG8_MMA(0, 1, At, B1); PG8_BAR;
            PG8_LDA(At, 1, 1); PG8_STAGE(PG8_SA(1, 0), a3, voffA);
            PG8_BAR; PG8_WAIT_L(0); PG8_MMA(1, 0, At, B0); PG8_BAR; PG8_SCHED;
            PG8_STAGE(PG8_SB(1, 1), b3 + hstep, voffB);
            PG8_WAIT_V(6); PG8_BAR; PG8_MMA(1, 1, At, B1); PG8_BAR;
            }
        }
        if constexpr (ALIGN_EPI) { if (wr == 0) PG8_BAR; }
        if constexpr (!Epi::AFTER_DRAIN) { E(acc, cur, wr, wc, fr, fq); S.done(cur); }
        if (!has_next) break;
#pragma unroll
        for (int a = 0; a < 2; ++a)
#pragma unroll
            for (int b = 0; b < 2; ++b)
#pragma unroll
                for (int m = 0; m < 4; ++m)
#pragma unroll
                    for (int n = 0; n < 2; ++n) acc[a][b][m][n] = (f32x4){0.f, 0.f, 0.f, 0.f};
        cur = nxt; cA = nA; cB = nB; ++ui;
        if constexpr (ALIGN_EPI) { if (wr == 1) PG8_BAR; }
    }
    PG8_WAIT_V(0);
    if constexpr (!ALIGN_EPI) { if (wr == 0) PG8_BAR; }
    PG8_BAR;
    if constexpr (Epi::AFTER_DRAIN) { E.fused(acc, cur, wr, wc, fr, fq, lds, wid, lane); S.done(cur); }
#undef PG8_SA
#undef PG8_SB
#undef PG8_STAGE
#undef PG8_LDA
#undef PG8_LDB
#undef PG8_MMA
#undef PG8_WAIT_V
#undef PG8_WAIT_L
#undef PG8_BAR
#undef PG8_SCHED
}
}

constexpr int NWAVES = 8, NTHR = 512;
constexpr int M = 18432, MP = 16384, D = 1024, NPROJ = 2560, DFF = 2816, NGU = 5632, SEQ = 8192;
constexpr int NCHUNK = M / 64;
constexpr float RMS_EPS = 1e-6f, LOG2E = 1.4426950408889634f;
constexpr int BPROJ = 1792;
enum { I_XP = 0, I_XS, I_CAK, I_CAV, I_SBW, I_SBS, I_CCK, I_CCV, I_SDC, I_NMIX, I_NFFN, I_NFIN, I_T5, I_WINE, I_WOUTE, I_SINK, I_MU, I_W0, I_W2, I_A0, I_A2, I_G2,
       I_KK, I_KA, I_RK, I_LNXW, I_LNXB, I_V0, I_V1, I_V2, I_WINO, I_WOUTO, I_CREL, I_DWW, I_DWB, I_LNG, I_LNB, I_FG, I_FU, I_FD, N_IN };
constexpr size_t O_YP = 0, O_YS = O_YP + (size_t)MP * D, O_PAK = O_YS + (size_t)2048 * D, O_PAV = O_PAK + 65536, O_PBW = O_PAV + 65536, O_PBS = O_PBW + 131072,
                 O_PCK = O_PBS + 7168, O_PCV = O_PCK + 1048576, O_PDC = O_PCV + 1048576, O_SAK = O_PDC + 61440, O_SAV = O_SAK + 524288, O_SBW = O_SAV + 524288,
                 O_SBS = O_SBW + 2097152, O_SCK = O_SBS + 114688, O_SCV = O_SCK + 2097152, O_SDC = O_SCV + 2097152, O_END = O_SDC + 983040;
static_assert(O_END == 29740032, "output map");
constexpr size_t MiB = 1u << 20;
constexpr size_t WS_CTL = 0, CTL_ZERO_BYTES = 64 * 1024;
constexpr size_t WS_W = 1 * MiB, W1_OFF = 0, W2_OFF = (size_t)NPROJ * D * 2, W3_OFF = W2_OFF + (size_t)D * D * 2, W4_OFF = W3_OFF + (size_t)NGU * D * 2, WL_STRIDE = W4_OFF + (size_t)D * DFF * 2;
constexpr size_t WS_XB = 96 * MiB;
constexpr size_t WS_P = 132 * MiB;
constexpr size_t WS_MIX = 222 * MiB;
constexpr size_t WS_H = WS_P;
constexpr size_t WS_V0 = 258 * MiB, WS_V1 = 276 * MiB, WS_R = 294 * MiB, WS_EM1 = 312 * MiB, WS_KH = 330 * MiB, WS_AA = 348 * MiB, WS_BB = 366 * MiB;
constexpr size_t WS_PHI = WS_P, WS_GAM = WS_P + 18 * MiB, WS_PSI = WS_P + 36 * MiB, WS_OME = WS_P + 54 * MiB, WS_SC = WS_P + 72 * MiB;
constexpr size_t WS_BONUS = 384 * MiB, WS_SS1 = WS_BONUS + (size_t)M * 8 * 4, WS_SS2 = WS_SS1 + (size_t)M * 16 * 4, WS_END = 387 * MiB;
static_assert(WS_W + 4 * WL_STRIDE <= WS_XB && WS_XB + (size_t)M * D * 2 <= WS_P && WS_P + (size_t)M * NPROJ * 2 <= WS_MIX && WS_MIX + (size_t)M * D * 2 <= WS_V0, "ws map");
static_assert(WS_H + (size_t)M * DFF * 2 <= WS_V0 && WS_SS2 + (size_t)M * 16 * 4 <= WS_END && (size_t)M * 512 * 4 <= (size_t)M * D * 2, "ws map 2");
constexpr size_t WS_LORA = WS_W + 4 * WL_STRIDE, LORA_W2 = 0, LORA_A2 = 65536, LORA_G2 = 131072, LORA_J = 262144, LORA_V1 = 2 * LORA_J, LORA_V2 = LORA_V1 + 32768;
static_assert(WS_LORA + LORA_V2 + 32768 <= WS_XB, "LoRA weight copies fit behind the GEMM weights");
constexpr int RING_BYTES = 131072, LDSCTL_OFF = RING_BYTES, MISC_OFF = LDSCTL_OFF + 320, LDS_BYTES = 147456;

#define GAS __attribute__((address_space(1)))
#define LAS __attribute__((address_space(3)))
typedef unsigned short bf16;
typedef unsigned v4u __attribute__((ext_vector_type(4)));
typedef unsigned v2u __attribute__((ext_vector_type(2)));
typedef float f32x4 __attribute__((ext_vector_type(4)));
typedef float f32x16 __attribute__((ext_vector_type(16)));
typedef short bf16x8 __attribute__((ext_vector_type(8)));
typedef short s16x4 __attribute__((ext_vector_type(4)));
typedef GAS unsigned gu32;
#define RLX_AGENT __ATOMIC_RELAXED, __HIP_MEMORY_SCOPE_AGENT
#define LDS_WAIT() asm volatile("s_waitcnt lgkmcnt(0)" ::: "memory")
#define VM_WAIT() asm volatile("s_waitcnt vmcnt(0)" ::: "memory")
__device__ __forceinline__ unsigned f2bf(float f) { unsigned u = __builtin_bit_cast(unsigned, f); return (u + 0x7fffu + ((u >> 16) & 1u)) >> 16; }
__device__ __forceinline__ unsigned pk2(float lo, float hi) { return pg8::cvt_pk_bf16(lo, hi); }
__device__ __forceinline__ float bf2f(unsigned h) { return __uint_as_float(h << 16); }
__device__ __forceinline__ float bflo(unsigned w) { return __uint_as_float(w << 16); }
__device__ __forceinline__ float bfhi(unsigned w) { return __uint_as_float(w & 0xffff0000u); }
__device__ __forceinline__ float wave_sum(float v) {
#pragma unroll
    for (int o = 1; o < 64; o <<= 1) v += __shfl_xor(v, o);
    return v;
}
__device__ __forceinline__ float row_ss(const GAS float* ssp, int row) {
    const GAS f32x4* p = (const GAS f32x4*)(ssp + (size_t)row * 16); const f32x4 a = p[0], b = p[1], c = p[2], d = p[3];
    return (((a.x + a.y) + (a.z + a.w)) + ((b.x + b.y) + (b.z + b.w))) + (((c.x + c.y) + (c.z + c.w)) + ((d.x + d.y) + (d.z + d.w)));
}
__device__ __forceinline__ void st16_wt(GAS void* p, v4u v) { asm volatile("global_store_dwordx4 %0, %1, off sc0 sc1\n\ts_nop 1" :: "v"(p), "v"(v) : "memory"); }
__device__ __forceinline__ v2u ld8_sys(const void* p) { const unsigned long long x = __hip_atomic_load((const unsigned long long*)p, __ATOMIC_RELAXED, __HIP_MEMORY_SCOPE_SYSTEM); return (v2u){(unsigned)x, (unsigned)(x >> 32)}; }
__device__ __forceinline__ bf16x8 ld16_sys(const void* p) { const v2u a = ld8_sys(p), b = ld8_sys((const char*)p + 8); return __builtin_bit_cast(bf16x8, (v4u){a.x, a.y, b.x, b.y}); }
__device__ __forceinline__ void st8_wt(void* p, v2u v) { __hip_atomic_store((unsigned long long*)p, ((unsigned long long)v.y << 32) | v.x, __ATOMIC_RELAXED, __HIP_MEMORY_SCOPE_SYSTEM); }
__device__ __forceinline__ float sigmoidf_(float x) { return 1.0f / (1.0f + __expf(-x)); }

#define XB_TMO      128
#define XB_XCNT(j)  (256  + 64 * (j))
#define XB_XSUB(j)  (1280 + 64 * (j))
#define XB_XGEN(j)  (2304 + 64 * (j))
#define XB_TOP      3328
#define XB_TOPGEN   3392
#define XCD_BAR_WORDS 3456
#define XB_SPIN_CAP (1u << 22)
__device__ __forceinline__ unsigned xb_ld(unsigned* p)              { return __hip_atomic_load(p, __ATOMIC_RELAXED, __HIP_MEMORY_SCOPE_AGENT); }
__device__ __forceinline__ unsigned xb_add(unsigned* p, unsigned v) { return __hip_atomic_fetch_add(p, v, __ATOMIC_RELAXED, __HIP_MEMORY_SCOPE_AGENT); }
__device__ __forceinline__ unsigned xb_xcc_id() { return (unsigned)__builtin_amdgcn_s_getreg((3 << 11) | 20) & 0xFu; }
#define XB_SPIN(cond, bar) do { unsigned _sp = 0; while (cond) { __builtin_amdgcn_s_sleep(1); \
    if ((++_sp & 255u) == 0u) { if (xb_ld(&(bar)[XB_TMO])) break; if (_sp > XB_SPIN_CAP) { atomicAdd(&(bar)[XB_TMO], 1u); break; } } } } while (0)
struct XcdBarrier { unsigned* bar; unsigned x; volatile LAS unsigned* st; };
__device__ __forceinline__ XcdBarrier xcd_barrier_post(unsigned* bar, volatile LAS unsigned* st) {
    XcdBarrier b; b.bar = bar; b.x = xb_xcc_id(); b.st = st;
    if (threadIdx.x == 0) (void)xb_add(&bar[XB_XCNT(b.x)], 1u);
    return b;
}
__device__ __forceinline__ void xcd_barrier_complete(unsigned* bar, unsigned x, unsigned& nloc, unsigned& nx) {
    const unsigned G = gridDim.x * gridDim.y * gridDim.z;
    unsigned sum, cnt, mine, sp = 0u;
    for (;;) {
        sum = 0u; cnt = 0u; mine = 0u;
#pragma unroll
        for (unsigned j = 0; j < 16; ++j) { const unsigned c = xb_ld(&bar[XB_XCNT(j)]); sum += c; cnt += (c > 0u) ? 1u : 0u; mine = (j == x) ? c : mine; }
        if (sum == G) break;
        __builtin_amdgcn_s_sleep(1);
        if ((++sp & 255u) == 0u) { if (xb_ld(&bar[XB_TMO])) break; if (sp > XB_SPIN_CAP) { atomicAdd(&bar[XB_TMO], 1u); break; } }
    }
    nloc = mine > 0u ? mine : 1u; nx = cnt > 0u ? cnt : 1u;
}
__device__ __forceinline__ void xcd_barrier(const XcdBarrier& b) {
    asm volatile("s_waitcnt vmcnt(0)" ::: "memory");
    __syncthreads();
    if (threadIdx.x == 0) {
        unsigned* bar = b.bar;
        __builtin_amdgcn_s_waitcnt(0);
        unsigned nloc = b.st[0], nx = b.st[1];
        if (nloc == 0u) { xcd_barrier_complete(bar, b.x, nloc, nx); b.st[0] = nloc; b.st[1] = nx; }
        const unsigned old = xb_add(&bar[XB_XSUB(b.x)], 1u);
        const unsigned gen = old / nloc;
        if (old + 1u == (gen + 1u) * nloc) {
            __builtin_amdgcn_fence(__ATOMIC_RELEASE, "agent");
            asm volatile("s_waitcnt vmcnt(0)" ::: "memory");
            const unsigned og = xb_add(&bar[XB_TOP], 1u);
            const unsigned tg = og / nx;
            if (og + 1u == (tg + 1u) * nx) xb_add(&bar[XB_TOPGEN], 1u);
            else XB_SPIN(xb_ld(&bar[XB_TOPGEN]) == tg, bar);
            __builtin_amdgcn_fence(__ATOMIC_ACQUIRE, "agent");
            xb_add(&bar[XB_XGEN(b.x)], 1u);
            asm volatile("s_waitcnt vmcnt(0)" ::: "memory");
        } else {
            XB_SPIN(xb_ld(&bar[XB_XGEN(b.x)]) == gen, bar);
            __builtin_amdgcn_fence(__ATOMIC_ACQUIRE, "agent");
            asm volatile("s_waitcnt vmcnt(0)" ::: "memory");
        }
    }
    __syncthreads();
}

struct Args { const float* in[N_IN]; float* out; unsigned char* ws; int ph_lo, ph_hi, use_bar, pad; };
struct Frame {
    LAS unsigned char* lds;
    int tid, lane, wave, G, bid, vsel;
    GAS float* out; GAS unsigned char* ws;
};

typedef __attribute__((address_space(4))) const char* kargp_t;
__device__ __forceinline__ const float* inp_(int idx) {
    kargp_t kp = (kargp_t)__builtin_amdgcn_kernarg_segment_ptr(); asm volatile("" : "+s"(kp));
    const float* q = *(const float* const __attribute__((address_space(4)))*)(kp + 8 * idx);
    return (const float*)(const GAS float*)q;
}
#define inp(F, idx) inp_(idx)
namespace pg8 {
struct EpiProj {
    static constexpr bool PERM = true, AFTER_DRAIN = false;
    GAS unsigned char* ws;
    __device__ __forceinline__ void operator()(const f32x4 (&acc)[2][2][4][2], const Unit& u, int wr, int wc, int fr, int fq) const {
        GAS bf16_t* P = (GAS bf16_t*)(ws + WS_P); const GAS float* ss = (const GAS float*)(ws + WS_SS2);
        const int row0 = u.pm * BM + wr * 64 + fr, col0 = u.pn * BM + wc * 32 + 8 * fq;
#pragma unroll
        for (int ai = 0; ai < 2; ++ai)
#pragma unroll
            for (int m = 0; m < 4; ++m) {
                const int row = row0 + ai * HALF + m * 16;
                const float sc = 1.0f / sqrtf(row_ss(ss, row) * (1.0f / 1024.0f) + 1e-6f);
#pragma unroll
                for (int bj = 0; bj < 2; ++bj) {
                    const f32x4 v0 = acc[ai][bj][m][0] * sc, v1 = acc[ai][bj][m][1] * sc;
                    u32x4 w; w.x = cvt_pk_bf16(v0[0], v0[1]); w.y = cvt_pk_bf16(v0[2], v0[3]); w.z = cvt_pk_bf16(v1[0], v1[1]); w.w = cvt_pk_bf16(v1[2], v1[3]);
                    *(GAS u32x4*)(P + (size_t)row * 2560 + col0 + bj * HALF) = w;
                }
                asm volatile("" ::: "memory");
            }
    }
};
struct EpiResid {
    static constexpr bool PERM = true, AFTER_DRAIN = false;
    GAS float* X; GAS unsigned char* ws; size_t ssoff;
    __device__ __forceinline__ void operator()(const f32x4 (&acc)[2][2][4][2], const Unit& u, int wr, int wc, int fr, int fq) const {
        GAS bf16_t* XB = (GAS bf16_t*)(ws + WS_XB); GAS float* ss = (GAS float*)(ws + ssoff);
        const int row0 = u.pm * BM + wr * 64 + fr, col0 = u.pn * BM + wc * 32 + 8 * fq;
#pragma unroll
        for (int ai = 0; ai < 2; ++ai)
#pragma unroll
            for (int m = 0; m < 4; ++m) {
                const int row = row0 + ai * HALF + m * 16; float q = 0.f;
#pragma unroll
                for (int bj = 0; bj < 2; ++bj) {
                    const int col = col0 + bj * HALF;
                    GAS float* xp = X + (size_t)row * 1024 + col;
                    f32x4 v0 = *(const GAS f32x4*)xp + acc[ai][bj][m][0], v1 = *(const GAS f32x4*)(xp + 4) + acc[ai][bj][m][1];
                    *(GAS f32x4*)xp = v0; *(GAS f32x4*)(xp + 4) = v1;
                    u32x4 w; w.x = cvt_pk_bf16(v0[0], v0[1]); w.y = cvt_pk_bf16(v0[2], v0[3]); w.z = cvt_pk_bf16(v1[0], v1[1]); w.w = cvt_pk_bf16(v1[2], v1[3]);
                    *(GAS u32x4*)(XB + (size_t)row * 1024 + col) = w;
                    q += (v0[0] * v0[0] + v0[1] * v0[1]) + (v0[2] * v0[2] + v0[3] * v0[3]) + (v1[0] * v1[0] + v1[1] * v1[1]) + (v1[2] * v1[2] + v1[3] * v1[3]);
                }
                q += __shfl_xor(q, 16); q += __shfl_xor(q, 32);
                if (fq == 0) ss[(size_t)row * 16 + u.pn * 4 + wc] = q;
                asm volatile("" ::: "memory");
            }
    }
};
struct EpiSwiglu {
    static constexpr bool PERM = true, AFTER_DRAIN = false;
    GAS unsigned char* ws;
    __device__ __forceinline__ void operator()(const f32x4 (&acc)[2][2][4][2], const Unit& u, int wr, int wc, int fr, int fq) const {
        GAS bf16_t* H = (GAS bf16_t*)(ws + WS_H); const GAS float* ss = (const GAS float*)(ws + WS_SS1);
        const int row0 = u.pm * BM + wr * 64 + fr, col0 = u.pn * HALF + wc * 32 + 8 * fq;
#pragma unroll
        for (int ai = 0; ai < 2; ++ai)
#pragma unroll
            for (int m = 0; m < 4; ++m) {
                const int row = row0 + ai * HALF + m * 16;
                const float sc = 1.0f / sqrtf(row_ss(ss, row) * (1.0f / 1024.0f) + 1e-6f);
                float h[8];
#pragma unroll
                for (int n = 0; n < 2; ++n)
#pragma unroll
                    for (int e = 0; e < 4; ++e) { const float g = acc[ai][0][m][n][e] * sc, up = acc[ai][1][m][n][e] * sc; h[n * 4 + e] = g / (1.0f + __expf(-g)) * up; }
                u32x4 w; w.x = cvt_pk_bf16(h[0], h[1]); w.y = cvt_pk_bf16(h[2], h[3]); w.z = cvt_pk_bf16(h[4], h[5]); w.w = cvt_pk_bf16(h[6], h[7]);
                *(GAS u32x4*)(H + (size_t)row * 2816 + col0) = w;
            }
    }
};
}

constexpr int IMG_STRIDE = 144, IMG_BYTES = 64 * IMG_STRIDE;
typedef short v4i16_t __attribute__((ext_vector_type(4)));
__device__ __forceinline__ bf16x8 tr_frag(const LAS unsigned char* img, int k0, int c0, int lane) {
    const LAS unsigned char* p = img + (k0 + 8 * (lane >> 4) + ((lane & 15) >> 2)) * IMG_STRIDE + (c0 + 4 * (lane & 3)) * 2;
    const v4i16_t lo = __builtin_amdgcn_ds_read_tr16_b64_v4i16((LAS v4i16_t*)p);
    const v4i16_t hi = __builtin_amdgcn_ds_read_tr16_b64_v4i16((LAS v4i16_t*)(p + 4 * IMG_STRIDE));
    return (bf16x8){lo[0], lo[1], lo[2], lo[3], hi[0], hi[1], hi[2], hi[3]};
}
__device__ __forceinline__ bf16x8 row_frag(const LAS unsigned char* img, int k0, int r0, int lane) {
    return *(const LAS bf16x8*)(img + (r0 + (lane & 15)) * IMG_STRIDE + (k0 + 8 * (lane >> 4)) * 2);
}
__device__ __forceinline__ void p0_transpose_item(const float* W, int K, int N, const float* sc, bf16* WT, int mode, LAS unsigned char* img, int item, int lane) {
    const int nblk = N / 64, kb = item / nblk, nb = item % nblk, k0 = 64 * kb, n0 = 64 * nb;
    const int drow0 = (mode == 0) ? n0 : (256 * (n0 >> 7) + (n0 & 127) + (mode == 2 ? 128 : 0));
    const int kr = lane >> 4, nc = lane & 15;
#pragma unroll
    for (int i = 0; i < 16; ++i) {
        const int k = 4 * i + kr;
        f32x4 v = *(const f32x4*)(W + (size_t)(k0 + k) * N + n0 + 4 * nc);
        if (sc) v = v * sc[k0 + k];
        v2u o; o.x = pk2(v.x, v.y); o.y = pk2(v.z, v.w);
        *(LAS v2u*)(img + k * IMG_STRIDE + nc * 8) = o;
    }
    LDS_WAIT(); asm volatile("" ::: "memory");
#pragma unroll
    for (int nq = 0; nq < 4; ++nq)
#pragma unroll
        for (int kh = 0; kh < 2; ++kh) {
            const bf16x8 f = tr_frag(img, 32 * kh, 16 * nq, lane);
            *(GAS bf16x8*)(WT + (size_t)(drow0 + 16 * nq + (lane & 15)) * K + k0 + 32 * kh + 8 * (lane >> 4)) = f;
        }
    LDS_WAIT(); asm volatile("" ::: "memory");
}
__device__ __forceinline__ void phase_prologue(Frame& F) {
    LAS unsigned char* scr = F.lds + F.wave * 16384;
    const int gw = F.bid * NWAVES + F.wave, NGW = F.G * NWAVES;
    constexpr int I1 = 16 * 40, I2 = 16 * 16, I3 = 16 * 44, I4 = 44 * 16, IL = I1 + I2 + 2 * I3 + I4;
    for (int it = gw; it < 4 * IL; it += NGW) {
        const int L = it / IL; int r = it - L * IL; const int j = L >> 1, odd = L & 1;
        unsigned char* wl = (unsigned char*)(F.ws + WS_W + (size_t)L * WL_STRIDE);
        if (r < I1) { p0_transpose_item(inp(F, odd ? I_WINO : I_WINE) + (size_t)j * D * NPROJ, D, NPROJ, inp(F, I_NMIX) + L * D, (bf16*)(wl + W1_OFF), 0, scr, r, F.lane); continue; } r -= I1;
        if (r < I2) { p0_transpose_item(inp(F, odd ? I_WOUTO : I_WOUTE) + (size_t)j * D * D, D, D, nullptr, (bf16*)(wl + W2_OFF), 0, scr, r, F.lane); continue; } r -= I2;
        if (r < I3) { p0_transpose_item(inp(F, I_FG) + (size_t)L * D * DFF, D, DFF, inp(F, I_NFFN) + L * D, (bf16*)(wl + W3_OFF), 1, scr, r, F.lane); continue; } r -= I3;
        if (r < I3) { p0_transpose_item(inp(F, I_FU) + (size_t)L * D * DFF, D, DFF, inp(F, I_NFFN) + L * D, (bf16*)(wl + W3_OFF), 2, scr, r, F.lane); continue; } r -= I3;
        p0_transpose_item(inp(F, I_FD) + (size_t)L * DFF * D, DFF, D, nullptr, (bf16*)(wl + W4_OFF), 0, scr, r, F.lane);
    }
    for (int it = gw; it < 2 * 32; it += NGW) { const int jj = it >> 5, r = it & 31; unsigned char* lb = (unsigned char*)(F.ws + WS_LORA + (size_t)jj * LORA_J);
        if (r < 8) p0_transpose_item(inp(F, I_W2) + (size_t)jj * 64 * 512, 64, 512, nullptr, (bf16*)(lb + LORA_W2), 0, scr, r, F.lane);
        else if (r < 16) p0_transpose_item(inp(F, I_A2) + (size_t)jj * 64 * 512, 64, 512, nullptr, (bf16*)(lb + LORA_A2), 0, scr, r - 8, F.lane);
        else p0_transpose_item(inp(F, I_G2) + (size_t)jj * 128 * 512, 128, 512, nullptr, (bf16*)(lb + LORA_G2), 0, scr, r - 16, F.lane); }
    { bf16* v1t = (bf16*)(F.ws + WS_LORA + LORA_V1); bf16* v2t = (bf16*)(F.ws + WS_LORA + LORA_V2); const float* v1 = inp(F, I_V1); const float* v2 = inp(F, I_V2);
      for (int e = F.bid * NTHR + F.tid; e < 2 * 16384; e += F.G * NTHR) {
          if (e < 16384) { const int q = e >> 9, cc = e & 511; v1t[e] = (bf16)f2bf(v1[cc * 32 + q]); }
          else { const int e2 = e - 16384, n = e2 >> 5, q = e2 & 31; v2t[e2] = (bf16)f2bf(v2[q * 512 + n]); } } }
    bf16* XB = (bf16*)(F.ws + WS_XB); float* ss2 = (float*)(F.ws + WS_SS2);
    for (int m = gw; m < M; m += NGW) {
        const float* xrow = (m < MP) ? inp(F, I_XP) + (size_t)m * D : inp(F, I_XS) + (size_t)(m - MP) * D;
        const GAS f32x4* xr = (const GAS f32x4*)xrow + F.lane;
        GAS f32x4* xo = (GAS f32x4*)(F.out + (size_t)m * D) + F.lane;
        GAS v2u* xb = (GAS v2u*)(XB + (size_t)m * D) + F.lane;
        float s = 0.f;
#pragma unroll
        for (int q = 0; q < 4; ++q) { const f32x4 v = xr[64 * q]; xo[64 * q] = v; s += (v.x * v.x + v.y * v.y) + (v.z * v.z + v.w * v.w); v2u o; o.x = pk2(v.x, v.y); o.y = pk2(v.z, v.w); xb[64 * q] = o; }
        s = wave_sum(s);
        if (F.lane < 16) ss2[(size_t)m * 16 + F.lane] = (F.lane == 0) ? s : 0.f;
    }
}
__device__ __forceinline__ void zero_f32(Frame& F, float* p, int n) { if (F.bid * NTHR < n) p[F.bid * NTHR + F.tid] = 0.f; }

constexpr int KS_STRIDE = 144;
constexpr int SLOT_BYTES = 64 * KS_STRIDE;
constexpr int ATT_K_OFF = 0, ATT_V_OFF = 4 * SLOT_BYTES, ATT_TAB_OFF = 8 * SLOT_BYTES, ATT_TAB_N = 640;
__device__ __forceinline__ int t5_bucket_dev(int rel) {
    const int n = rel < 0 ? -rel : rel;
    const int l = n < 8 ? n : (n < 12 ? 8 : (n < 16 ? 9 : (n < 23 ? 10 : (n < 32 ? 11 : (n < 46 ? 12 : (n < 64 ? 13 : (n < 91 ? 14 : 15)))))));
    return (rel > 0 ? 16 : 0) + l;
}
template <bool ISC>
__device__ __forceinline__ void attn_unit(Frame& F, int j, int unit) {
    const int tid = F.tid, lane = F.lane, w = F.wave, r32 = lane & 31, hi = lane >> 5;
    const int c = unit >> 1, sub = unit & 1;
    const bool samp = c >= 256; const int bs = c - 256, cl = c & 127;
    const int g = w >> 1, half = w & 1;
    const int head = sub * 4 + g;
    const int NLEFT = ISC ? 8 : 2;
    const bf16* P = (const bf16*)(F.ws + WS_P);
    LAS unsigned char* lds = F.lds;
    LAS float* tab = (LAS float*)(lds + ATT_TAB_OFF);
    if (ISC) { const float* tb = inp(F, I_CREL) + (size_t)j * 8 * 257;
        for (int e = tid; e < 4 * ATT_TAB_N; e += NTHR) { const int gg = e / ATT_TAB_N, i = e - gg * ATT_TAB_N; int dist = i - 63; dist = dist < -128 ? -128 : (dist > 128 ? 128 : dist);
            tab[e] = tb[(sub * 4 + gg) * 257 + dist + 128] * LOG2E; }
    } else { const float* tb = inp(F, I_T5);
        for (int e = tid; e < 4 * ATT_TAB_N; e += NTHR) { const int gg = e / ATT_TAB_N, i = e - gg * ATT_TAB_N; const int rel = i - 191;
            tab[e] = (i < 255) ? tb[t5_bucket_dev(rel) * 8 + (sub * 4 + gg)] * LOG2E : 0.f; }
    }
    const int tq = 32 * half + r32;
    bf16x8 qf[4];
    { const bf16* qp = P + (size_t)(64 * c + tq) * NPROJ + head * 64 + 8 * hi;
#pragma unroll
      for (int ks = 0; ks < 4; ++ks) qf[ks] = *(const bf16x8*)(qp + 16 * ks); }
    float mrun, lrun;
    if (ISC) { mrun = -1e30f; lrun = 0.f; } else { mrun = inp(F, I_SINK)[j * 8 + head] * LOG2E; lrun = 1.f; }
    f32x16 o0, o1;
#pragma unroll
    for (int r = 0; r < 16; ++r) { o0[r] = 0.f; o1[r] = 0.f; }
    const int slot = ISC ? g : 0;
    LAS unsigned char* Kb = lds + ATT_K_OFF + slot * SLOT_BYTES;
    LAS unsigned char* Vb = lds + ATT_V_OFF + slot * SLOT_BYTES;
    const LAS float* mytab = tab + g * ATT_TAB_N;
    const int skey = tid >> 3, sdch = tid & 7;
    for (int tau = 0; tau <= NLEFT; ++tau) {
        if (!samp && cl - NLEFT + tau < 0) continue;
        __syncthreads();
        const bool fromcache = samp && tau < NLEFT;
#pragma unroll
        for (int s = 0; s < (ISC ? 4 : 1); ++s) {
            float kv[8], vv[8];
            if (fromcache) {
                const int pos = 64 * tau + skey;
                const float* kp; const float* vp;
                if (ISC) { const size_t o = ((size_t)(j * 32 + bs) * 512 + pos) * 512 + (sub * 4 + s) * 64 + sdch * 8; kp = inp(F, I_CCK) + o; vp = inp(F, I_CCV) + o; }
                else     { const size_t o = ((size_t)(j * 32 + bs) * 128 + pos) * 128 + sub * 64 + sdch * 8; kp = inp(F, I_CAK) + o; vp = inp(F, I_CAV) + o; }
                const f32x4 a0 = *(const f32x4*)kp, a1 = *(const f32x4*)(kp + 4), b0 = *(const f32x4*)vp, b1 = *(const f32x4*)(vp + 4);
                kv[0] = a0.x; kv[1] = a0.y; kv[2] = a0.z; kv[3] = a0.w; kv[4] = a1.x; kv[5] = a1.y; kv[6] = a1.z; kv[7] = a1.w;
                vv[0] = b0.x; vv[1] = b0.y; vv[2] = b0.z; vv[3] = b0.w; vv[4] = b1.x; vv[5] = b1.y; vv[6] = b1.z; vv[7] = b1.w;
            } else {
                const int krow = 64 * (c - NLEFT + tau) + skey;
                const bf16* kp = P + (size_t)krow * NPROJ + (ISC ? (512 + (sub * 4 + s) * 64) : (512 + sub * 64)) + sdch * 8;
                const bf16* vp = P + (size_t)krow * NPROJ + (ISC ? (1024 + (sub * 4 + s) * 64) : (640 + sub * 64)) + sdch * 8;
                const v4u a = *(const v4u*)kp, b = *(const v4u*)vp;
                kv[0] = bflo(a.x); kv[1] = bfhi(a.x); kv[2] = bflo(a.y); kv[3] = bfhi(a.y); kv[4] = bflo(a.z); kv[5] = bfhi(a.z); kv[6] = bflo(a.w); kv[7] = bfhi(a.w);
                vv[0] = bflo(b.x); vv[1] = bfhi(b.x); vv[2] = bflo(b.y); vv[3] = bfhi(b.y); vv[4] = bflo(b.z); vv[5] = bfhi(b.z); vv[6] = bflo(b.w); vv[7] = bfhi(b.w);
            }
            v4u kw; kw.x = pk2(kv[0], kv[1]); kw.y = pk2(kv[2], kv[3]); kw.z = pk2(kv[4], kv[5]); kw.w = pk2(kv[6], kv[7]);
            *(LAS v4u*)(lds + ATT_K_OFF + s * SLOT_BYTES + skey * KS_STRIDE + sdch * 16) = kw;
#pragma unroll
            for (int e = 0; e < 8; ++e) *(LAS unsigned short*)(lds + ATT_V_OFF + s * SLOT_BYTES + (sdch * 8 + e) * KS_STRIDE + skey * 2) = (unsigned short)f2bf(vv[e]);
        }
        __syncthreads();
        f32x16 s0, s1;
#pragma unroll
        for (int r = 0; r < 16; ++r) { s0[r] = 0.f; s1[r] = 0.f; }
#pragma unroll
        for (int ks = 0; ks < 4; ++ks) {
            const bf16x8 k0 = *(const LAS bf16x8*)(Kb + r32 * KS_STRIDE + (16 * ks + 8 * hi) * 2);
            const bf16x8 k1 = *(const LAS bf16x8*)(Kb + (32 + r32) * KS_STRIDE + (16 * ks + 8 * hi) * 2);
            s0 = __builtin_amdgcn_mfma_f32_32x32x16_bf16(k0, qf[ks], s0, 0, 0, 0);
            s1 = __builtin_amdgcn_mfma_f32_32x32x16_bf16(k1, qf[ks], s1, 0, 0, 0);
        }
        const float qscale = 0.125f * LOG2E;
        float mt = -1e30f;
#pragma unroll
        for (int r = 0; r < 16; ++r) {
            const int key = (r & 3) + 8 * (r >> 2) + 4 * hi;
            const int i0 = ISC ? (tq - key + 63 + (8 - tau) * 64) : (64 * tau + key - tq + 63);
            const int i1 = ISC ? (i0 - 32) : (i0 + 32);
            s0[r] = s0[r] * qscale + mytab[i0]; s1[r] = s1[r] * qscale + mytab[i1];
            mt = fmaxf(mt, fmaxf(s0[r], s1[r]));
        }
        mt = fmaxf(mt, __shfl_xor(mt, 32));
        const float mnew = fmaxf(mrun, mt), alpha = exp2f(mrun - mnew);
        float ls = 0.f;
#pragma unroll
        for (int r = 0; r < 16; ++r) { s0[r] = exp2f(s0[r] - mnew); s1[r] = exp2f(s1[r] - mnew); ls += s0[r] + s1[r]; }
        ls += __shfl_xor(ls, 32);
        lrun = lrun * alpha + ls; mrun = mnew;
#pragma unroll
        for (int r = 0; r < 16; ++r) { o0[r] *= alpha; o1[r] *= alpha; }
#pragma unroll
        for (int kb = 0; kb < 2; ++kb)
#pragma unroll
            for (int s = 0; s < 2; ++s) {
                const f32x16& sv = kb ? s1 : s0;
                v4u pw; pw.x = pg8::cvt_pk_bf16(sv[8 * s + 0], sv[8 * s + 1]); pw.y = pg8::cvt_pk_bf16(sv[8 * s + 2], sv[8 * s + 3]);
                        pw.z = pg8::cvt_pk_bf16(sv[8 * s + 4], sv[8 * s + 5]); pw.w = pg8::cvt_pk_bf16(sv[8 * s + 6], sv[8 * s + 7]);
                const bf16x8 pf = __builtin_bit_cast(bf16x8, pw);
                const int koff = (32 * kb + 16 * s + 4 * hi) * 2;
                const v2u a0 = *(const LAS v2u*)(Vb + r32 * KS_STRIDE + koff), a1 = *(const LAS v2u*)(Vb + r32 * KS_STRIDE + koff + 16);
                const v2u c0 = *(const LAS v2u*)(Vb + (32 + r32) * KS_STRIDE + koff), c1 = *(const LAS v2u*)(Vb + (32 + r32) * KS_STRIDE + koff + 16);
                v4u va; va.x = a0.x; va.y = a0.y; va.z = a1.x; va.w = a1.y;
                v4u vc; vc.x = c0.x; vc.y = c0.y; vc.z = c1.x; vc.w = c1.y;
                o0 = __builtin_amdgcn_mfma_f32_32x32x16_bf16(__builtin_bit_cast(bf16x8, va), pf, o0, 0, 0, 0);
                o1 = __builtin_amdgcn_mfma_f32_32x32x16_bf16(__builtin_bit_cast(bf16x8, vc), pf, o1, 0, 0, 0);
            }
    }
    const float inv = 1.0f / lrun;
    bf16* MIX = (bf16*)(F.ws + WS_MIX);
    bf16* op = MIX + (size_t)(64 * c + tq) * D + head * 64 + 4 * hi;
#pragma unroll
    for (int q4 = 0; q4 < 4; ++q4) {
        v2u a; a.x = pk2(o0[4 * q4] * inv, o0[4 * q4 + 1] * inv); a.y = pk2(o0[4 * q4 + 2] * inv, o0[4 * q4 + 3] * inv);
        v2u b; b.x = pk2(o1[4 * q4] * inv, o1[4 * q4 + 1] * inv); b.y = pk2(o1[4 * q4 + 2] * inv, o1[4 * q4 + 3] * inv);
        *(v2u*)(op + 8 * q4) = a; *(v2u*)(op + 32 + 8 * q4) = b;
    }
    __syncthreads();
}

__device__ __forceinline__ void copy8(const bf16* src, float* dst) {
    const v4u a = *(const v4u*)src;
    f32x4 lo, hi; lo.x = bflo(a.x); lo.y = bfhi(a.x); lo.z = bflo(a.y); lo.w = bfhi(a.y); hi.x = bflo(a.z); hi.y = bfhi(a.z); hi.z = bflo(a.w); hi.w = bfhi(a.w);
    *(f32x4*)dst = lo; *(f32x4*)(dst + 4) = hi;
}
__device__ __forceinline__ void side_outputs(Frame& F, int j, int odd) {
    const int gw = F.bid * NWAVES + F.wave, NGW = F.G * NWAVES, lane = F.lane;
    const bf16* P = (const bf16*)(F.ws + WS_P);
    const int win = odd ? 512 : 128, pitch = odd ? 512 : 128, nrow = 2 * win + 2048, vcol = odd ? 1024 : 640;
    for (int it = gw; it < 2 * nrow; it += NGW) {
        const int isv = it & 1, r = it >> 1; size_t srow, doff;
        if (r < 2 * win) { const int b = r / win, tt = r - b * win; srow = (size_t)b * SEQ + (SEQ - win) + tt;
            doff = (odd ? (isv ? O_PCV : O_PCK) : (isv ? O_PAV : O_PAK)) + ((size_t)(j * 2 + b) * win + tt) * pitch; }
        else { const int rs = r - 2 * win; srow = (size_t)MP + rs; doff = (odd ? (isv ? O_SCV : O_SCK) : (isv ? O_SAV : O_SAK)) + ((size_t)j * 2048 + rs) * pitch; }
        if (lane * 8 < pitch) copy8(P + srow * NPROJ + (isv ? vcol : 512) + lane * 8, (float*)(F.out + doff + lane * 8));
    }
    if (!odd) for (int it = gw; it < 34 * 4; it += NGW) {
        const int r = it >> 2, q = it & 3; size_t srow, doff;
        if (r < 2) { srow = (size_t)r * SEQ + SEQ - 1; doff = O_PBS + (size_t)(j * 2 + r) * BPROJ; } else { srow = (size_t)MP + (r - 2) * 64 + 63; doff = O_SBS + (size_t)(j * 32 + (r - 2)) * BPROJ; }
        if (lane < 56) copy8(P + srow * NPROJ + 768 + q * 448 + lane * 8, (float*)(F.out + doff + q * 448 + lane * 8));
    }
}
__device__ __forceinline__ void conv_unit(Frame& F, int j, int unit) {
    const int tid = F.tid, lane = F.lane, w = F.wave, ch = tid;
    const int row0 = 32 * unit, c = row0 >> 6; const bool samp = c >= 256; const int bs = c - 256, bp = c >> 7;
    const int t0 = samp ? (row0 & 63) : (row0 & 8191);
    const bf16* P = (const bf16*)(F.ws + WS_P);
    LAS float* zbuf = (LAS float*)F.lds;
    float uu[62];
#pragma unroll
    for (int i = 0; i < 62; ++i) {
        const int tl = t0 - 30 + i;
        float u = 0.f;
        if (tl >= 0) { const bf16* p = P + (size_t)(row0 - 30 + i) * NPROJ + 1536 + ch; const float a = bf2f(p[0]), gt = bf2f(p[512]); u = a * sigmoidf_(gt); }
        else if (samp) u = inp(F, I_SDC)[((size_t)(j * 32 + bs) * 30 + (30 + tl)) * 512 + ch];
        uu[i] = u;
    }
    float dw[31];
#pragma unroll
    for (int k = 0; k < 31; ++k) dw[k] = inp(F, I_DWW)[((size_t)j * 31 + k) * 512 + ch];
    const float db = inp(F, I_DWB)[j * 512 + ch];
#pragma unroll
    for (int t = 0; t < 32; ++t) {
        float z = db;
#pragma unroll
        for (int k = 0; k < 31; ++k) z += dw[k] * uu[t + k];
        zbuf[t * 512 + ch] = z;
        const int tl = t0 + t;
        if (samp) { if (tl >= 34) F.out[O_SDC + ((size_t)(j * 32 + bs) * 30 + (tl - 34)) * 512 + ch] = uu[30 + t]; }
        else if (tl >= 8162) F.out[O_PDC + ((size_t)(j * 2 + bp) * 30 + (tl - 8162)) * 512 + ch] = uu[30 + t];
    }
    __syncthreads();
    bf16* MIX = (bf16*)(F.ws + WS_MIX);
    const float* lg = inp(F, I_LNG) + j * 512; const float* lb = inp(F, I_LNB) + j * 512;
#pragma unroll
    for (int tt = 0; tt < 4; ++tt) {
        const int t = 4 * w + tt; float v[8]; float s = 0.f;
#pragma unroll
        for (int k = 0; k < 8; ++k) { v[k] = zbuf[t * 512 + lane + 64 * k]; s += v[k]; }
        const float mean = wave_sum(s) * (1.0f / 512.0f); float q = 0.f;
#pragma unroll
        for (int k = 0; k < 8; ++k) { v[k] -= mean; q += v[k] * v[k]; }
        const float rstd = 1.0f / sqrtf(wave_sum(q) * (1.0f / 512.0f) + 1e-5f);
#pragma unroll
        for (int k = 0; k < 8; ++k) { const int cc = lane + 64 * k; const float zn = v[k] * rstd * lg[cc] + lb[cc]; MIX[(size_t)(row0 + t) * D + 512 + cc] = (bf16)f2bf(zn * sigmoidf_(zn)); }
    }
    __syncthreads();
}

constexpr int B1_T = 16;
constexpr int B1_XR = 0, B1_XK = 32768, B1_XV = 65536, B1_AW = 98304, B1_AD = B1_AW + 2304, B1_AG = B1_AD + 2304, B1_AV = B1_AG + 4352, B1_AL = B1_AV + 16640, B1_END = B1_AL + 1280;
static_assert(B1_END <= RING_BYTES, "B1 LDS");
__device__ __forceinline__ f32x4 b1_mm(const LAS unsigned char* img, int stride, int ksteps, const bf16* WT, int K, int n0, int lane) {
    f32x4 acc = {0.f, 0.f, 0.f, 0.f};
    const LAS unsigned char* ap = img + (lane & 15) * stride + (lane >> 4) * 16;
    const bf16* bp = WT + (size_t)(n0 + (lane & 15)) * K + 8 * (lane >> 4);
    for (int ks = 0; ks < ksteps; ++ks) acc = __builtin_amdgcn_mfma_f32_16x16x32_bf16(*(const LAS bf16x8*)(ap + 64 * ks), *(const bf16x8*)(bp + 32 * ks), acc, 0, 0, 0);
    return acc;
}
__device__ __forceinline__ void rwkv_b1_unit(Frame& F, int j, int unit) {
    const int tid = F.tid, lane = F.lane, w = F.wave, fr = lane & 15, fq = lane >> 4;
    const int row0 = B1_T * unit, c = row0 >> 6; const bool samp = c >= 256; const int bs = c - 256;
    const int t0 = samp ? (row0 & 63) : (row0 & 8191);
    const bf16* P = (const bf16*)(F.ws + WS_P);
    LAS unsigned char* L = F.lds;
    if (tid < 224) {
        const int col = 8 * tid;
        const float* mu = inp(F, I_MU) + j * BPROJ + col;
        const f32x4 m0 = *(const f32x4*)mu, m1 = *(const f32x4*)(mu + 4);
        const float mm[8] = {m0.x, m0.y, m0.z, m0.w, m1.x, m1.y, m1.z, m1.w};
        float prev[8];
        if (t0 == 0) { if (samp) { const float* sp = inp(F, I_SBS) + (size_t)(j * 32 + bs) * BPROJ + col; const f32x4 a = *(const f32x4*)sp, b = *(const f32x4*)(sp + 4);
                                   prev[0] = a.x; prev[1] = a.y; prev[2] = a.z; prev[3] = a.w; prev[4] = b.x; prev[5] = b.y; prev[6] = b.z; prev[7] = b.w; }
                       else { for (int e = 0; e < 8; ++e) prev[e] = 0.f; } }
        else { const v4u a = *(const v4u*)(P + (size_t)(row0 - 1) * NPROJ + 768 + col);
               prev[0] = bflo(a.x); prev[1] = bfhi(a.x); prev[2] = bflo(a.y); prev[3] = bfhi(a.y); prev[4] = bflo(a.z); prev[5] = bfhi(a.z); prev[6] = bflo(a.w); prev[7] = bfhi(a.w); }
        v4u raw[B1_T];
#pragma unroll
        for (int t = 0; t < B1_T; ++t) raw[t] = *(const v4u*)(P + (size_t)(row0 + t) * NPROJ + 768 + col);
#pragma unroll
        for (int t = 0; t < B1_T; ++t) {
            const float cur[8] = {bflo(raw[t].x), bfhi(raw[t].x), bflo(raw[t].y), bfhi(raw[t].y), bflo(raw[t].z), bfhi(raw[t].z), bflo(raw[t].w), bfhi(raw[t].w)};
            float x[8];
#pragma unroll
            for (int e = 0; e < 8; ++e) { x[e] = cur[e] + (prev[e] - cur[e]) * mm[e]; prev[e] = cur[e]; }
            if (col < 512 || (col >= 576 && col < 1600)) {
                const int reg = col < 512 ? B1_XR : (col < 1088 ? B1_XK : B1_XV), cc = col < 512 ? col : (col < 1088 ? col - 576 : col - 1088);
                LAS float* d = (LAS float*)(L + reg) + t * 512 + cc;
                *(LAS f32x4*)d = (f32x4){x[0], x[1], x[2], x[3]}; *(LAS f32x4*)(d + 4) = (f32x4){x[4], x[5], x[6], x[7]};
                if (col >= 1088) { v4u o; o.x = pk2(x[0], x[1]); o.y = pk2(x[2], x[3]); o.z = pk2(x[4], x[5]); o.w = pk2(x[6], x[7]); *(LAS v4u*)(L + B1_AV + t * 1040 + cc * 2) = o; }
            } else {
                int off;
                if (col < 576) { off = B1_AW + t * 144 + (col - 512) * 2;
#pragma unroll
                    for (int e = 0; e < 8; ++e) x[e] = tanhf(x[e]); }
                else if (col < 1664) off = B1_AD + t * 144 + (col - 1600) * 2;
                else { off = B1_AG + t * 272 + (col - 1664) * 2;
#pragma unroll
                    for (int e = 0; e < 8; ++e) x[e] = sigmoidf_(x[e]); }
                v4u o; o.x = pk2(x[0], x[1]); o.y = pk2(x[2], x[3]); o.z = pk2(x[4], x[5]); o.w = pk2(x[6], x[7]); *(LAS v4u*)(L + off) = o;
            }
        }
    }
    __syncthreads();
    const bf16* LW = (const bf16*)(F.ws + WS_LORA + (size_t)j * LORA_J);
    if (j > 0 && w < 2) {
        const f32x4 a = b1_mm(L + B1_AV, 1040, 16, (const bf16*)(F.ws + WS_LORA + LORA_V1), 512, 16 * w, lane);
#pragma unroll
        for (int e = 0; e < 4; ++e) *(LAS unsigned short*)(L + B1_AL + (4 * fq + e) * 80 + (16 * w + fr) * 2) = (unsigned short)f2bf(a[e]);
    }
    if (j > 0) __syncthreads();
    f32x4 lw[4], la[4], lg[4], lv[4];
#pragma unroll
    for (int nt = 0; nt < 4; ++nt) {
        const int n0 = 64 * w + 16 * nt;
        lw[nt] = b1_mm(L + B1_AW, 144, 2, (const bf16*)((const unsigned char*)LW + LORA_W2), 64, n0, lane);
        la[nt] = b1_mm(L + B1_AD, 144, 2, (const bf16*)((const unsigned char*)LW + LORA_A2), 64, n0, lane);
        lg[nt] = b1_mm(L + B1_AG, 272, 4, (const bf16*)((const unsigned char*)LW + LORA_G2), 128, n0, lane);
        lv[nt] = (j > 0) ? b1_mm(L + B1_AL, 80, 1, (const bf16*)(F.ws + WS_LORA + LORA_V2), 32, n0, lane) : (f32x4){0.f, 0.f, 0.f, 0.f};
    }
    bf16* Vcur = (bf16*)(F.ws + (j == 0 ? WS_V0 : WS_V1)); const bf16* Vfirst = (const bf16*)(F.ws + WS_V0);
    bf16* R = (bf16*)(F.ws + WS_R); bf16* EM1 = (bf16*)(F.ws + WS_EM1); bf16* KH = (bf16*)(F.ws + WS_KH); bf16* AA = (bf16*)(F.ws + WS_AA); bf16* BB = (bf16*)(F.ws + WS_BB);
    bf16* MIX = (bf16*)(F.ws + WS_MIX); float* BON = (float*)(F.ws + WS_BONUS);
    float pw0[4], pa0[4], pkk[4], pka[4], prk[4], pv0[4];
#pragma unroll
    for (int nt = 0; nt < 4; ++nt) { const int ch = 64 * w + 16 * nt + fr;
        pw0[nt] = inp(F, I_W0)[j * 512 + ch]; pa0[nt] = inp(F, I_A0)[j * 512 + ch]; pkk[nt] = inp(F, I_KK)[j * 512 + ch]; pka[nt] = inp(F, I_KA)[j * 512 + ch]; prk[nt] = inp(F, I_RK)[j * 512 + ch];
        pv0[nt] = (j > 0) ? inp(F, I_V0)[(j - 1) * 512 + ch] : 0.f; }
#pragma unroll
    for (int e = 0; e < 4; ++e) {
        const int t = 4 * fq + e; const size_t orow = (size_t)(row0 + t) * 512;
        float kkv[4], khv[4], rv[4], av[4]; float nsq = 0.f, bon = 0.f;
#pragma unroll
        for (int nt = 0; nt < 4; ++nt) {
            const int ch = 64 * w + 16 * nt + fr; const size_t o = orow + ch;
            const float xw = pw0[nt] + lw[nt][e];
            const float sp = (-xw > 20.f) ? -xw : log1pf(__expf(-xw));
            const float lwd = -__expf(-sp - 0.5f);
            const float a = sigmoidf_(pa0[nt] + la[nt][e]);
            const float r = ((const LAS float*)(L + B1_XR))[t * 512 + ch], k = ((const LAS float*)(L + B1_XK))[t * 512 + ch]; float v = ((const LAS float*)(L + B1_XV))[t * 512 + ch];
            if (j > 0) { const float vf = bf2f(Vfirst[o]); v = v + (vf - v) * sigmoidf_(pv0[nt] + lv[nt][e]); }
            kkv[nt] = k * pkk[nt]; nsq += kkv[nt] * kkv[nt];
            khv[nt] = k * (1.0f + (a - 1.0f) * pka[nt]); bon += r * khv[nt] * prk[nt]; rv[nt] = r; av[nt] = a;
            R[o] = (bf16)f2bf(r); EM1[o] = (bf16)f2bf(lwd); KH[o] = (bf16)f2bf(khv[nt]); Vcur[o] = (bf16)f2bf(v);
            MIX[(size_t)(row0 + t) * D + 512 + ch] = (bf16)f2bf(lg[nt][e]);
        }
        nsq += __shfl_xor(nsq, 1); nsq += __shfl_xor(nsq, 2); nsq += __shfl_xor(nsq, 4); nsq += __shfl_xor(nsq, 8);
        bon += __shfl_xor(bon, 1); bon += __shfl_xor(bon, 2); bon += __shfl_xor(bon, 4); bon += __shfl_xor(bon, 8);
        const float inv = 1.0f / fmaxf(sqrtf(nsq), 1e-12f);
#pragma unroll
        for (int nt = 0; nt < 4; ++nt) { const size_t o = orow + 64 * w + 16 * nt + fr; const float kk = kkv[nt] * inv; AA[o] = (bf16)f2bf(-kk); BB[o] = (bf16)f2bf(kk * av[nt]); }
        if (fr == 0) BON[(size_t)(row0 + t) * 8 + w] = bon;
    }
    __syncthreads();
}

template <bool ATR, bool BTR>
__device__ __forceinline__ f32x4 mm16(const LAS unsigned char* Aimg, int a0, const LAS unsigned char* Bimg, int b0, f32x4 acc, int lane) {
#pragma unroll
    for (int ks = 0; ks < 2; ++ks) {
        const bf16x8 af = ATR ? tr_frag(Aimg, 32 * ks, a0, lane) : row_frag(Aimg, 32 * ks, a0, lane);
        const bf16x8 bfr = BTR ? tr_frag(Bimg, 32 * ks, b0, lane) : row_frag(Bimg, 32 * ks, b0, lane);
        acc = __builtin_amdgcn_mfma_f32_16x16x32_bf16(af, bfr, acc, 0, 0, 0);
    }
    return acc;
}
__device__ __forceinline__ void st_T(LAS unsigned char* img, int r0, int c0, f32x4 v, int lane) {
    v2u w; w.x = pk2(v[0], v[1]); w.y = pk2(v[2], v[3]);
    *(LAS v2u*)(img + (c0 + (lane & 15)) * IMG_STRIDE + (r0 + 4 * (lane >> 4)) * 2) = w;
}
__device__ __forceinline__ f32x4 ld_T(const LAS unsigned char* img, int r0, int c0, int lane) {
    const v2u w = *(const LAS v2u*)(img + (c0 + (lane & 15)) * IMG_STRIDE + (r0 + 4 * (lane >> 4)) * 2);
    return (f32x4){bflo(w.x), bfhi(w.x), bflo(w.y), bfhi(w.y)};
}
__device__ __forceinline__ void st_T_g(bf16* slice, int r0, int c0, f32x4 v, int lane) {
    v2u w; w.x = pk2(v[0], v[1]); w.y = pk2(v[2], v[3]);
    st8_wt(slice + (size_t)(c0 + (lane & 15)) * 512 + r0 + 4 * (lane >> 4), w);
}
__device__ __forceinline__ void rwkv_pre_unit(Frame& F, int unit) {
    const int tid = F.tid, lane = F.lane, w = F.wave;
    const int c = unit >> 3, h = unit & 7;
    const size_t sl = (size_t)(64 * c) * 512 + 64 * h;
    const bf16* Rg = (const bf16*)(F.ws + WS_R) + sl; const bf16* LWg = (const bf16*)(F.ws + WS_EM1) + sl; const bf16* KHg = (const bf16*)(F.ws + WS_KH) + sl; const bf16* AAg = (const bf16*)(F.ws + WS_AA) + sl; const bf16* BBg = (const bf16*)(F.ws + WS_BB) + sl;
    bf16* PHIg = (bf16*)(F.ws + WS_PHI) + sl; bf16* GAMg = (bf16*)(F.ws + WS_GAM) + sl; bf16* PSIg = (bf16*)(F.ws + WS_PSI) + sl; bf16* OMEg = (bf16*)(F.ws + WS_OME) + sl;
    LAS unsigned char* L = F.lds;
#define IMG(k) (L + (k) * IMG_BYTES)
    LAS float* gt = (LAS float*)(L + 12 * IMG_BYTES);
    LAS float* WLs = gt + 8 * 64;
    {
        const bf16* Vg = (const bf16*)(F.ws + WS_V0) + sl; const bf16* Vg1 = (const bf16*)(F.ws + WS_V1) + sl;
        float ld[8], cum[8]; float run = 0.f;
#pragma unroll
        for (int q = 0; q < 8; ++q) { ld[q] = bf2f(LWg[(size_t)(8 * w + q) * 512 + lane]); run += ld[q]; cum[q] = run; }
        gt[w * 64 + lane] = run;
        __syncthreads();
        float pre = 0.f, tot = 0.f;
#pragma unroll
        for (int g2 = 0; g2 < 8; ++g2) { const float x = gt[g2 * 64 + lane]; tot += x; if (g2 < w) pre += x; }
        if (w == 0) WLs[lane] = __expf(tot);
#pragma unroll
        for (int q = 0; q < 8; ++q) {
            const int t = 8 * w + q; const size_t o = (size_t)t * 512 + lane;
            const float cu = pre + cum[q], cx = cu - ld[q];
            const float a = bf2f(AAg[o]), b = bf2f(BBg[o]), r = bf2f(Rg[o]), k = bf2f(KHg[o]);
            const float ein = __expf(-cu), eo = __expf(tot - cu);
            const int off = t * IMG_STRIDE + lane * 2;
            *(LAS unsigned short*)(IMG(0) + off) = (unsigned short)f2bf(a * __expf(cx));
            *(LAS unsigned short*)(IMG(1) + off) = (unsigned short)f2bf(r * __expf(cu));
            *(LAS unsigned short*)(IMG(2) + off) = (unsigned short)f2bf(b * ein);
            *(LAS unsigned short*)(IMG(3) + off) = (unsigned short)f2bf(k * ein);
            *(LAS unsigned short*)(IMG(4) + off) = (unsigned short)f2bf(b * eo);
            *(LAS unsigned short*)(IMG(5) + off) = (unsigned short)f2bf(k * eo);
            *(LAS unsigned short*)(IMG(6) + off) = F.vsel ? Vg1[o] : Vg[o];
        }
    }
    __syncthreads();
    const f32x4 zero4 = {0.f, 0.f, 0.f, 0.f};
    {
        const int mtx = w >> 1;
        const LAS unsigned char* Aimg = (mtx & 1) ? IMG(3) : IMG(2);
        const LAS unsigned char* Bimg = (mtx & 2) ? IMG(1) : IMG(0);
        LAS unsigned char* dst = IMG(7 + mtx);
        const bool incl = (mtx & 2) != 0;
#pragma unroll
        for (int q = 0; q < 8; ++q) {
            const int idx = 8 * (w & 1) + q, sr = idx >> 2, tc = idx & 3;
            f32x4 acc = zero4;
            if (sr <= tc) {
                acc = mm16<false, false>(Aimg, 16 * sr, Bimg, 16 * tc, acc, lane);
                if (sr == tc) {
#pragma unroll
                    for (int e = 0; e < 4; ++e) { const int s_ = 4 * (lane >> 4) + e, t_ = lane & 15; const bool keep = incl ? (s_ <= t_) : (s_ < t_); acc[e] = keep ? acc[e] : 0.f; }
                }
            }
            st_T(dst, 16 * sr, 16 * tc, acc, lane);
        }
    }
    __syncthreads();
    {
        const int t0 = 2 * w, t1 = 2 * w + 1;
#pragma unroll
        for (int q = 0; q < 2; ++q) {
            const int idx = q ? t1 : t0, sr = idx >> 2, tc = idx & 3;
            f32x4 acc = mm16<true, false>(IMG(7), 16 * sr, IMG(7), 16 * tc, zero4, lane);
            st_T(IMG(11), 16 * sr, 16 * tc, acc, lane);
            f32x4 tv = ld_T(IMG(7), 16 * sr, 16 * tc, lane);
#pragma unroll
            for (int e = 0; e < 4; ++e) tv[e] += (sr == tc && 4 * (lane >> 4) + e == (lane & 15)) ? 1.0f : 0.f;
            st_T(IMG(2), 16 * sr, 16 * tc, tv, lane);
        }
        __syncthreads();
#pragma unroll
        for (int it = 0; it < 4; ++it) {
            const LAS unsigned char* Pc = (it & 1) ? IMG(7) : IMG(11); LAS unsigned char* Pn = (it & 1) ? IMG(11) : IMG(7);
            const LAS unsigned char* Tc = (it & 1) ? IMG(3) : IMG(2);  LAS unsigned char* Tn = (it & 1) ? IMG(2) : IMG(3);
#pragma unroll
            for (int q = 0; q < 2; ++q) {
                const int idx = q ? t1 : t0, sr = idx >> 2, tc = idx & 3;
                f32x4 tv = ld_T(Tc, 16 * sr, 16 * tc, lane);
                tv = mm16<true, false>(Tc, 16 * sr, Pc, 16 * tc, tv, lane);
                st_T(Tn, 16 * sr, 16 * tc, tv, lane);
                f32x4 pv = mm16<true, false>(Pc, 16 * sr, Pc, 16 * tc, zero4, lane);
                st_T(Pn, 16 * sr, 16 * tc, pv, lane);
            }
            __syncthreads();
        }
#pragma unroll
        for (int q = 0; q < 2; ++q) {
            const int idx = q ? t1 : t0, sr = idx >> 2, tc = idx & 3;
            f32x4 tv = ld_T(IMG(2), 16 * sr, 16 * tc, lane);
            tv = mm16<true, false>(IMG(2), 16 * sr, IMG(11), 16 * tc, tv, lane);
            st_T(IMG(3), 16 * sr, 16 * tc, tv, lane);
        }
        __syncthreads();
#pragma unroll
        for (int q = 0; q < 2; ++q) {
            const int idx = q ? t1 : t0, sr = idx >> 2, tc = idx & 3;
            f32x4 xv = mm16<true, false>(IMG(0), 16 * sr, IMG(3), 16 * tc, zero4, lane);
            st_T(IMG(7), 16 * sr, 16 * tc, xv, lane);
            f32x4 wv = mm16<true, false>(IMG(8), 16 * sr, IMG(3), 16 * tc, zero4, lane);
            st_T(IMG(11), 16 * sr, 16 * tc, wv, lane);
        }
        __syncthreads();
#pragma unroll
        for (int q = 0; q < 2; ++q) {
            const int idx = q ? t1 : t0, sr = idx >> 2, tc = idx & 3;
            f32x4 zv = mm16<true, false>(IMG(6), 16 * sr, IMG(11), 16 * tc, zero4, lane);
            st_T(IMG(2), 16 * sr, 16 * tc, zv, lane);
            f32x4 ph = mm16<true, true>(IMG(7), 16 * sr, IMG(4), 16 * tc, zero4, lane);
            { const float wl = (sr == tc) ? WLs[16 * sr + (lane & 15)] : 0.f;
#pragma unroll
              for (int e = 0; e < 4; ++e) ph[e] += (4 * (lane >> 4) + e == (lane & 15)) ? wl : 0.f; }
            st_T(IMG(0), 16 * sr, 16 * tc, ph, lane);
            f32x4 ps = ld_T(IMG(1), 16 * sr, 16 * tc, lane);
            ps = mm16<true, false>(IMG(7), 16 * sr, IMG(9), 16 * tc, ps, lane);
            st_T(IMG(3), 16 * sr, 16 * tc, ps, lane);
        }
        __syncthreads();
#pragma unroll
        for (int q = 0; q < 2; ++q) {
            const int idx = q ? t1 : t0, sr = idx >> 2, tc = idx & 3;
            f32x4 ga = mm16<true, true>(IMG(4), 16 * sr, IMG(2), 16 * tc, zero4, lane);
            ga = mm16<true, true>(IMG(5), 16 * sr, IMG(6), 16 * tc, ga, lane);
            st_T(IMG(8), 16 * sr, 16 * tc, ga, lane);
            f32x4 om = mm16<false, true>(IMG(9), 16 * sr, IMG(2), 16 * tc, zero4, lane);
            om = mm16<false, true>(IMG(10), 16 * sr, IMG(6), 16 * tc, om, lane);
            st_T(IMG(11), 16 * sr, 16 * tc, om, lane);
        }
    }
    __syncthreads();
    { const int row = tid >> 3, pc = tid & 7; const size_t go = (size_t)row * 512 + pc * 8; const int lo = row * IMG_STRIDE + pc * 16;
      *(v4u*)(PHIg + go) = *(const LAS v4u*)(IMG(0) + lo); *(v4u*)(PSIg + go) = *(const LAS v4u*)(IMG(3) + lo);
      *(v4u*)(GAMg + go) = *(const LAS v4u*)(IMG(8) + lo); *(v4u*)(OMEg + go) = *(const LAS v4u*)(IMG(11) + lo); }
    __syncthreads();
#undef IMG
}
__device__ __forceinline__ void rwkv_scan_wave(Frame& F, int j, bool samp, int b, int h, int ih) {
    const int lane = F.lane, r32 = lane & 31, hi = lane >> 5;
    const int nch = samp ? 1 : 128;
    const int c0 = samp ? (256 + b) : (128 * b);
    const int i = 32 * ih + r32;
    const bf16* PH = (const bf16*)(F.ws + WS_PHI); const bf16* GA = (const bf16*)(F.ws + WS_GAM); bf16* SC = (bf16*)(F.ws + WS_SC);
    f32x16 s0, s1;
    if (samp) { const float* st = inp(F, I_SBW) + (((size_t)(j * 32 + b) * 8 + h) * 64 + i) * 64;
#pragma unroll
        for (int q4 = 0; q4 < 4; ++q4) { const f32x4 a = *(const f32x4*)(st + 8 * q4 + 4 * hi), c = *(const f32x4*)(st + 32 + 8 * q4 + 4 * hi);
            s0[4 * q4] = a.x; s0[4 * q4 + 1] = a.y; s0[4 * q4 + 2] = a.z; s0[4 * q4 + 3] = a.w; s1[4 * q4] = c.x; s1[4 * q4 + 1] = c.y; s1[4 * q4 + 2] = c.z; s1[4 * q4 + 3] = c.w; }
    } else {
#pragma unroll
        for (int r = 0; r < 16; ++r) { s0[r] = 0.f; s1[r] = 0.f; }
    }
    v2u pfN[2][2][2][2]; v2u gfN[2][4];
#define SCAN_LOAD(CHUNK) do { const size_t sl_ = (size_t)(64 * (CHUNK)) * 512 + 64 * h; \
        _Pragma("unroll") for (int jbp = 0; jbp < 2; ++jbp) _Pragma("unroll") for (int jb = 0; jb < 2; ++jb) _Pragma("unroll") for (int s = 0; s < 2; ++s) { \
            const bf16* p_ = PH + sl_ + (size_t)(32 * jbp + r32) * 512 + 32 * jb + 16 * s + 4 * hi; pfN[jbp][jb][s][0] = ld8_sys(p_); pfN[jbp][jb][s][1] = ld8_sys(p_ + 8); } \
        _Pragma("unroll") for (int jbp = 0; jbp < 2; ++jbp) _Pragma("unroll") for (int q4 = 0; q4 < 4; ++q4) gfN[jbp][q4] = ld8_sys(GA + sl_ + (size_t)i * 512 + 32 * jbp + 8 * q4 + 4 * hi); } while (0)
    SCAN_LOAD(c0);
    for (int cc = 0; cc < nch; ++cc) {
        const size_t sl = (size_t)(64 * (c0 + cc)) * 512 + 64 * h;
        asm volatile("s_waitcnt vmcnt(0)" ::: "memory");
        __builtin_amdgcn_sched_barrier(0);
        v2u pf[2][2][2][2]; v2u gf[2][4];
#pragma unroll
        for (int jbp = 0; jbp < 2; ++jbp) {
#pragma unroll
            for (int jb = 0; jb < 2; ++jb)
#pragma unroll
                for (int s = 0; s < 2; ++s) { pf[jbp][jb][s][0] = pfN[jbp][jb][s][0]; pf[jbp][jb][s][1] = pfN[jbp][jb][s][1]; }
#pragma unroll
            for (int q4 = 0; q4 < 4; ++q4) gf[jbp][q4] = gfN[jbp][q4];
        }
        bf16x8 bfr[2][2];
#pragma unroll
        for (int jb = 0; jb < 2; ++jb) {
            const f32x16& sv = jb ? s1 : s0;
            v4u lo, hi4; lo.x = pk2(sv[0], sv[1]); lo.y = pk2(sv[2], sv[3]); lo.z = pk2(sv[4], sv[5]); lo.w = pk2(sv[6], sv[7]);
            hi4.x = pk2(sv[8], sv[9]); hi4.y = pk2(sv[10], sv[11]); hi4.z = pk2(sv[12], sv[13]); hi4.w = pk2(sv[14], sv[15]);
            bfr[jb][0] = __builtin_bit_cast(bf16x8, lo); bfr[jb][1] = __builtin_bit_cast(bf16x8, hi4);
            bf16* sp = SC + sl + (size_t)i * 512 + 32 * jb + 4 * hi;
            v2u t0; t0.x = lo.x; t0.y = lo.y; st8_wt(sp, t0); t0.x = lo.z; t0.y = lo.w; st8_wt(sp + 8, t0);
            t0.x = hi4.x; t0.y = hi4.y; st8_wt(sp + 16, t0); t0.x = hi4.z; t0.y = hi4.w; st8_wt(sp + 24, t0);
        }
        __builtin_amdgcn_sched_barrier(0);
        { const int cn = (cc + 1 < nch) ? (c0 + cc + 1) : (c0 + cc); SCAN_LOAD(cn); }
        __builtin_amdgcn_sched_barrier(0);
        f32x16 n0, n1;
#pragma unroll
        for (int q4 = 0; q4 < 4; ++q4) {
            n0[4 * q4] = bflo(gf[0][q4].x); n0[4 * q4 + 1] = bfhi(gf[0][q4].x); n0[4 * q4 + 2] = bflo(gf[0][q4].y); n0[4 * q4 + 3] = bfhi(gf[0][q4].y);
            n1[4 * q4] = bflo(gf[1][q4].x); n1[4 * q4 + 1] = bfhi(gf[1][q4].x); n1[4 * q4 + 2] = bflo(gf[1][q4].y); n1[4 * q4 + 3] = bfhi(gf[1][q4].y);
        }
#pragma unroll
        for (int jb = 0; jb < 2; ++jb)
#pragma unroll
            for (int s = 0; s < 2; ++s) {
                v4u a0; a0.x = pf[0][jb][s][0].x; a0.y = pf[0][jb][s][0].y; a0.z = pf[0][jb][s][1].x; a0.w = pf[0][jb][s][1].y;
                v4u a1; a1.x = pf[1][jb][s][0].x; a1.y = pf[1][jb][s][0].y; a1.z = pf[1][jb][s][1].x; a1.w = pf[1][jb][s][1].y;
                n0 = __builtin_amdgcn_mfma_f32_32x32x16_bf16(__builtin_bit_cast(bf16x8, a0), bfr[jb][s], n0, 0, 0, 0);
                n1 = __builtin_amdgcn_mfma_f32_32x32x16_bf16(__builtin_bit_cast(bf16x8, a1), bfr[jb][s], n1, 0, 0, 0);
            }
        s0 = n0; s1 = n1;
        asm volatile("s_nop 15\n\ts_nop 15" : "+v"(s0), "+v"(s1));
        __builtin_amdgcn_sched_barrier(0);
    }
    asm volatile("s_waitcnt vmcnt(0)" ::: "memory");
#undef SCAN_LOAD
    float* so = (float*)F.out + (samp ? O_SBW : O_PBW) + (((size_t)(j * (samp ? 32 : 2) + b) * 8 + h) * 64 + i) * 64;
#pragma unroll
    for (int q4 = 0; q4 < 4; ++q4) {
        *(f32x4*)(so + 8 * q4 + 4 * hi) = (f32x4){s0[4 * q4], s0[4 * q4 + 1], s0[4 * q4 + 2], s0[4 * q4 + 3]};
        *(f32x4*)(so + 32 + 8 * q4 + 4 * hi) = (f32x4){s1[4 * q4], s1[4 * q4 + 1], s1[4 * q4 + 2], s1[4 * q4 + 3]};
    }
}
constexpr int SCR_D = 8, SCR_R = 10, SCR_SLOT = 12288;
__device__ __forceinline__ void rwkv_scan_prompt_wg(Frame& F, int j, int b, int h, int ih) {
    const int lane = F.lane, w = F.wave, r32 = lane & 31, hi = lane >> 5;
    const int c0 = 128 * b, nch = 128;
    const bf16* PH = (const bf16*)(F.ws + WS_PHI); const bf16* GA = (const bf16*)(F.ws + WS_GAM); bf16* SC = (bf16*)(F.ws + WS_SC);
    LAS unsigned char* ring = F.lds;
#define SCR_WAITV(n) asm volatile("s_waitcnt vmcnt(" #n ")" ::: "memory")
    if (w >= 1 && w <= 6) {
        const int rr = lane >> 3, pc = (lane & 7) ^ rr;
        size_t goff[2]; int loff[2]; const bf16* gb[2];
#pragma unroll
        for (int q = 0; q < 2; ++q) { const int k = 2 * (w - 1) + q;
            if (k < 8) { gb[q] = PH; goff[q] = (size_t)(8 * k + rr) * 512 + pc * 8; loff[q] = k * 1024; }
            else { gb[q] = GA; goff[q] = (size_t)(32 * ih + 8 * (k - 8) + rr) * 512 + pc * 8; loff[q] = 8192 + (k - 8) * 1024; } }
#define SCR_ISSUE(STEP) do { const size_t sl_ = (size_t)(64 * (c0 + (STEP))) * 512 + 64 * h; const int so_ = ((STEP) % SCR_R) * SCR_SLOT; \
        _Pragma("unroll") for (int q = 0; q < 2; ++q) __builtin_amdgcn_global_load_lds((const unsigned*)(gb[q] + sl_ + goff[q]), (LAS unsigned*)(ring + so_ + loff[q]), 16, 0, 0); } while (0)
        for (int x = 0; x < SCR_D; ++x) SCR_ISSUE(x);
        SCR_WAITV(14);
        __builtin_amdgcn_s_barrier();
        for (int cc = 0; cc < nch; ++cc) {
            if (cc + SCR_D < nch) { SCR_ISSUE(cc + SCR_D); SCR_WAITV(14); } else { SCR_WAITV(0); }
            __builtin_amdgcn_s_barrier();
        }
#undef SCR_ISSUE
    } else if (w == 7) {
        __builtin_amdgcn_s_barrier();
        for (int cc = 0; cc < nch; ++cc) __builtin_amdgcn_s_barrier();
    } else {
        const int i = 32 * ih + r32;
        f32x16 s0, s1;
#pragma unroll
        for (int r = 0; r < 16; ++r) { s0[r] = 0.f; s1[r] = 0.f; }
        __builtin_amdgcn_s_barrier();
        for (int cc = 0; cc < nch; ++cc) {
            const size_t sl = (size_t)(64 * (c0 + cc)) * 512 + 64 * h;
            const LAS unsigned char* slot = ring + (cc % SCR_R) * SCR_SLOT;
            v2u pf[2][2][2][2]; v2u gf[2][4];
#pragma unroll
            for (int jbp = 0; jbp < 2; ++jbp) {
                const int row = 32 * jbp + r32;
#pragma unroll
                for (int jb = 0; jb < 2; ++jb)
#pragma unroll
                    for (int s = 0; s < 2; ++s)
#pragma unroll
                        for (int pz = 0; pz < 2; ++pz) { const int e0 = 32 * jb + 16 * s + 4 * hi + 8 * pz;
                            pf[jbp][jb][s][pz] = *(const LAS v2u*)(slot + row * 128 + ((((e0 >> 3) ^ (row & 7)) << 4) | ((e0 & 4) << 1))); }
#pragma unroll
                for (int q4 = 0; q4 < 4; ++q4) { const int e0 = 32 * jbp + 8 * q4 + 4 * hi;
                    gf[jbp][q4] = *(const LAS v2u*)(slot + 8192 + r32 * 128 + ((((e0 >> 3) ^ (r32 & 7)) << 4) | ((e0 & 4) << 1))); }
            }
            bf16x8 bfr[2][2];
#pragma unroll
            for (int jb = 0; jb < 2; ++jb) {
                const f32x16& sv = jb ? s1 : s0;
                v4u lo, hi4; lo.x = pk2(sv[0], sv[1]); lo.y = pk2(sv[2], sv[3]); lo.z = pk2(sv[4], sv[5]); lo.w = pk2(sv[6], sv[7]);
                hi4.x = pk2(sv[8], sv[9]); hi4.y = pk2(sv[10], sv[11]); hi4.z = pk2(sv[12], sv[13]); hi4.w = pk2(sv[14], sv[15]);
                bfr[jb][0] = __builtin_bit_cast(bf16x8, lo); bfr[jb][1] = __builtin_bit_cast(bf16x8, hi4);
                bf16* sp = SC + sl + (size_t)i * 512 + 32 * jb + 4 * hi;
                v2u t0; t0.x = lo.x; t0.y = lo.y; *(v2u*)(sp) = t0; t0.x = lo.z; t0.y = lo.w; *(v2u*)(sp + 8) = t0;
                t0.x = hi4.x; t0.y = hi4.y; *(v2u*)(sp + 16) = t0; t0.x = hi4.z; t0.y = hi4.w; *(v2u*)(sp + 24) = t0;
            }
            f32x16 n0, n1;
#pragma unroll
            for (int q4 = 0; q4 < 4; ++q4) {
                n0[4 * q4] = bflo(gf[0][q4].x); n0[4 * q4 + 1] = bfhi(gf[0][q4].x); n0[4 * q4 + 2] = bflo(gf[0][q4].y); n0[4 * q4 + 3] = bfhi(gf[0][q4].y);
                n1[4 * q4] = bflo(gf[1][q4].x); n1[4 * q4 + 1] = bfhi(gf[1][q4].x); n1[4 * q4 + 2] = bflo(gf[1][q4].y); n1[4 * q4 + 3] = bfhi(gf[1][q4].y);
            }
#pragma unroll
            for (int jb = 0; jb < 2; ++jb)
#pragma unroll
                for (int s = 0; s < 2; ++s) {
                    v4u a0; a0.x = pf[0][jb][s][0].x; a0.y = pf[0][jb][s][0].y; a0.z = pf[0][jb][s][1].x; a0.w = pf[0][jb][s][1].y;
                    v4u a1; a1.x = pf[1][jb][s][0].x; a1.y = pf[1][jb][s][0].y; a1.z = pf[1][jb][s][1].x; a1.w = pf[1][jb][s][1].y;
                    n0 = __builtin_amdgcn_mfma_f32_32x32x16_bf16(__builtin_bit_cast(bf16x8, a0), bfr[jb][s], n0, 0, 0, 0);
                    n1 = __builtin_amdgcn_mfma_f32_32x32x16_bf16(__builtin_bit_cast(bf16x8, a1), bfr[jb][s], n1, 0, 0, 0);
                }
            s0 = n0; s1 = n1;
            asm volatile("s_nop 15\n\ts_nop 15" : "+v"(s0), "+v"(s1));
            asm volatile("s_waitcnt lgkmcnt(0)" ::: "memory");
            __builtin_amdgcn_s_barrier();
        }
        float* so = (float*)F.out + O_PBW + (((size_t)(j * 2 + b) * 8 + h) * 64 + i) * 64;
#pragma unroll
        for (int q4 = 0; q4 < 4; ++q4) {
            *(f32x4*)(so + 8 * q4 + 4 * hi) = (f32x4){s0[4 * q4], s0[4 * q4 + 1], s0[4 * q4 + 2], s0[4 * q4 + 3]};
            *(f32x4*)(so + 32 + 8 * q4 + 4 * hi) = (f32x4){s1[4 * q4], s1[4 * q4 + 1], s1[4 * q4 + 2], s1[4 * q4 + 3]};
        }
    }
#undef SCR_WAITV
    asm volatile("s_waitcnt vmcnt(0)" ::: "memory");
    __syncthreads();
}
__device__ __forceinline__ void phase_scan(Frame& F, int j) {
    if (F.bid < 32) rwkv_scan_prompt_wg(F, j, F.bid >> 4, (F.bid >> 1) & 7, F.bid & 1);
    else { const int u = (F.bid - 32) * NWAVES + F.wave; if (u < 512) rwkv_scan_wave(F, j, true, u >> 4, (u >> 1) & 7, u & 1); }
}
__device__ __forceinline__ void rwkv_out_unit(Frame& F, int j, int c) {
    const int lane = F.lane, h = F.wave;
    const size_t sl = (size_t)(64 * c) * 512 + 64 * h;
    const bf16* PS = (const bf16*)(F.ws + WS_PSI) + sl; const bf16* OM = (const bf16*)(F.ws + WS_OME) + sl; const bf16* SC = (const bf16*)(F.ws + WS_SC) + sl;
    const bf16* V = (const bf16*)(F.ws + (j == 0 ? WS_V0 : WS_V1)) + sl; const float* BON = (const float*)(F.ws + WS_BONUS);
    bf16* MIX = (bf16*)(F.ws + WS_MIX);
    const int fr = lane & 15, fq = lane >> 4;
    bf16x8 af[4][2], bfm[4][2];
#pragma unroll
    for (int q = 0; q < 4; ++q)
#pragma unroll
        for (int ks = 0; ks < 2; ++ks) { af[q][ks] = ld16_sys(PS + (size_t)(16 * q + fr) * 512 + 32 * ks + 8 * fq); bfm[q][ks] = ld16_sys(SC + (size_t)(16 * q + fr) * 512 + 32 * ks + 8 * fq); }
    const float lw[4] = {inp(F, I_LNXW)[j * 512 + 64 * h + fr], inp(F, I_LNXW)[j * 512 + 64 * h + 16 + fr], inp(F, I_LNXW)[j * 512 + 64 * h + 32 + fr], inp(F, I_LNXW)[j * 512 + 64 * h + 48 + fr]};
    const float lb[4] = {inp(F, I_LNXB)[j * 512 + 64 * h + fr], inp(F, I_LNXB)[j * 512 + 64 * h + 16 + fr], inp(F, I_LNXB)[j * 512 + 64 * h + 32 + fr], inp(F, I_LNXB)[j * 512 + 64 * h + 48 + fr]};
#pragma unroll
    for (int tr = 0; tr < 4; ++tr) {
        f32x4 y[4];
#pragma unroll
        for (int ic = 0; ic < 4; ++ic) {
            const v2u ow = ld8_sys(OM + (size_t)(16 * ic + fr) * 512 + 16 * tr + 4 * fq);
            f32x4 acc = {bflo(ow.x), bfhi(ow.x), bflo(ow.y), bfhi(ow.y)};
            acc = __builtin_amdgcn_mfma_f32_16x16x32_bf16(af[tr][0], bfm[ic][0], acc, 0, 0, 0);
            acc = __builtin_amdgcn_mfma_f32_16x16x32_bf16(af[tr][1], bfm[ic][1], acc, 0, 0, 0);
            y[ic] = acc;
        }
#pragma unroll
        for (int e = 0; e < 4; ++e) {
            float sm = (y[0][e] + y[1][e]) + (y[2][e] + y[3][e]);
            sm += __shfl_xor(sm, 1); sm += __shfl_xor(sm, 2); sm += __shfl_xor(sm, 4); sm += __shfl_xor(sm, 8);
            const float mean = sm * (1.0f / 64.0f);
            const float d0 = y[0][e] - mean, d1 = y[1][e] - mean, d2 = y[2][e] - mean, d3 = y[3][e] - mean;
            float q = (d0 * d0 + d1 * d1) + (d2 * d2 + d3 * d3);
            q += __shfl_xor(q, 1); q += __shfl_xor(q, 2); q += __shfl_xor(q, 4); q += __shfl_xor(q, 8);
            const float rstd = 1.0f / sqrtf(q * (1.0f / 64.0f) + 64e-5f);
            const int row = 64 * c + 16 * tr + 4 * fq + e;
            const float bon = BON[(size_t)row * 8 + h];
            const float dd[4] = {d0, d1, d2, d3};
#pragma unroll
            for (int ic = 0; ic < 4; ++ic) {
                const int ch = 16 * ic + fr;
                const float v = bf2f(V[(size_t)(16 * tr + 4 * fq + e) * 512 + ch]);
                bf16* mp = MIX + (size_t)row * D + 512 + 64 * h + ch;
                const float g = bf2f(*mp);
                *mp = (bf16)f2bf((dd[ic] * rstd * lw[ic] + lb[ic] + bon * v) * g);
            }
        }
    }
}
__device__ __forceinline__ void phase_post(Frame& F, int j) { for (int c = F.bid; c < NCHUNK; c += F.G) rwkv_out_unit(F, j, c); }
__device__ __forceinline__ void phase_final(Frame& F) {
    const GAS float* ss2 = (const GAS float*)(F.ws + WS_SS2); const float* gf = inp(F, I_NFIN);
    const int gw = F.bid * NWAVES + F.wave, NGW = F.G * NWAVES;
    for (int m = gw; m < M; m += NGW) {
        const float sc = 1.0f / sqrtf(row_ss(ss2, m) * (1.0f / 1024.0f) + RMS_EPS);
        GAS f32x4* xo = (GAS f32x4*)(F.out + (size_t)m * D) + F.lane;
#pragma unroll
        for (int q = 0; q < 4; ++q) { f32x4 v = xo[64 * q]; const f32x4 g = *((const GAS f32x4*)gf + F.lane + 64 * q); v = v * sc * g; xo[64 * q] = v; }
    }
}

constexpr int N_PHASES = 34;
#ifndef MK_DUP
#define MK_DUP 0ull
#endif
#ifndef MK_DUPU
#define MK_DUPU 0
#endif
#ifndef MK_SKIP
#define MK_SKIP 0ull
#endif
#ifndef MK_LAST
#define MK_LAST N_PHASES
#endif
#ifndef MK_PER_PHASE
#define MK_PER_PHASE 0
#endif
#ifndef MK_NOSTATE
#define MK_NOSTATE 0
#endif
#ifndef MK_DUMPSEL
#define MK_DUMPSEL 0
#endif
#ifndef PH_MASK
#define PH_MASK 0xFFFF
#endif
__host__ __device__ inline bool phase_exists(int p) { if (p == 0 || p == N_PHASES - 1) return true; const int L = (p - 1) / 8, s = (p - 1) % 8; return !((L & 1) && (s >= 2 && s <= 4)); }

__global__ void __launch_bounds__(NTHR, 2) mk_fwd(Args args) {
    extern __shared__ __attribute__((aligned(16))) unsigned char lds_raw[];
    Frame F;
    F.lds = (LAS unsigned char*)lds_raw;
    F.tid = threadIdx.x; F.lane = F.tid & 63; F.wave = __builtin_amdgcn_readfirstlane(F.tid >> 6);
    F.G = gridDim.x; F.bid = blockIdx.x; F.out = (GAS float*)args.out; F.ws = (GAS unsigned char*)args.ws;
    volatile LAS unsigned* MISC = (volatile LAS unsigned*)(F.lds + MISC_OFF);
    for (int u = F.tid; u < (LDS_BYTES - LDSCTL_OFF) / 4; u += NTHR) ((LAS unsigned*)(F.lds + LDSCTL_OFF))[u] = 0u;
    __syncthreads();
    XcdBarrier bar; bar.bar = (unsigned*)(F.ws + WS_CTL) + 4096; bar.x = 0; bar.st = nullptr;
    if (args.use_bar) bar = xcd_barrier_post((unsigned*)(F.ws + WS_CTL) + 4096, MISC + 8);
    bool first = true;
    for (int p = args.ph_lo; p < args.ph_hi; ++p) {
        if (!phase_exists(p)) continue;
      for (int rep = 0; rep < (((MK_DUP >> p) & 1ull) ? 2 : 1); ++rep) {
        if (!first) xcd_barrier(bar);
        first = false;
        { int t_ = threadIdx.x; asm volatile("" : "+v"(t_)); F.tid = t_; F.lane = t_ & 63; F.wave = __builtin_amdgcn_readfirstlane(t_ >> 6); unsigned char* ws_ = args.ws; float* out_ = args.out; F.G = gridDim.x; F.bid = blockIdx.x; asm volatile("" : "+s"(ws_), "+s"(out_), "+s"(F.G), "+s"(F.bid)); F.ws = (GAS unsigned char*)ws_; F.out = (GAS float*)out_; }
        if (p == 0) { if constexpr (PH_MASK & 1) phase_prologue(F); continue; }
        if (p == N_PHASES - 1) { if constexpr (PH_MASK & 256) phase_final(F); continue; }
        const int L = (p - 1) / 8, s = (p - 1) % 8, j = L >> 1, odd = L & 1; F.vsel = j;
        unsigned char* wl = (unsigned char*)(F.ws + WS_W + (size_t)L * WL_STRIDE);
        bf16* XB = (bf16*)(F.ws + WS_XB); bf16* P = (bf16*)(F.ws + WS_P); bf16* MIX = (bf16*)(F.ws + WS_MIX); bf16* H = (bf16*)(F.ws + WS_H);
        float* ss1 = (float*)(F.ws + WS_SS1); float* ss2 = (float*)(F.ws + WS_SS2);
        if (s == 0) {
            pg8::Gemm g{XB, (const bf16*)(wl + W1_OFF), M, NPROJ, D}; pg8::StaticOrder S; S.init(M, NPROJ, F.G, F.bid);
            pg8::EpiProj E{F.ws};
            if constexpr (PH_MASK & 2) pg8::gemm_phase<pg8::EpiProj, pg8::StaticOrder, true, true>(F.lds, g, S, E);
        } else if (s == 1) {
            if constexpr (PH_MASK & 2048) side_outputs(F, j, odd);
            if (odd) { for (int it = F.bid; it < 1152; it += F.G) { if (it < 576) { for (int r_ = 0; r_ < ((MK_DUPU & 8) ? 2 : 1); ++r_) attn_unit<true>(F, j, it); } else { for (int r_ = 0; r_ < ((MK_DUPU & 4) ? 2 : 1); ++r_) conv_unit(F, j, it - 576); } } }
            else { for (int it = F.bid; it < 576 + M / B1_T; it += F.G) { if (it < 576) { for (int r_ = 0; r_ < ((MK_DUPU & 2) ? 2 : 1); ++r_) attn_unit<false>(F, j, it); } else { for (int r_ = 0; r_ < ((MK_DUPU & 1) ? 2 : 1); ++r_) rwkv_b1_unit(F, j, it - 576); } } }
        } else if (s == 2) { if constexpr (PH_MASK & 4096) { for (int it = F.bid; it < NCHUNK * 8; it += F.G) rwkv_pre_unit(F, it); }
        } else if (s == 3) { if constexpr (PH_MASK & 16) phase_scan(F, j);
        } else if (s == 4) { if constexpr (PH_MASK & 32) phase_post(F, j);
        } else if (s == 5) {
            pg8::Gemm g{MIX, (const bf16*)(wl + W2_OFF), M, D, D}; pg8::StaticOrder S; S.init(M, D, F.G, F.bid);
            pg8::EpiResid E{F.out, F.ws, WS_SS1};
            if constexpr (PH_MASK & 64) pg8::gemm_phase<pg8::EpiResid, pg8::StaticOrder, true, true>(F.lds, g, S, E);
        } else if (s == 6) {
            pg8::Gemm g{XB, (const bf16*)(wl + W3_OFF), M, NGU, D}; pg8::StaticOrder S; S.init(M, NGU, F.G, F.bid);
            pg8::EpiSwiglu E{F.ws};
            if constexpr (PH_MASK & 128) pg8::gemm_phase<pg8::EpiSwiglu, pg8::StaticOrder, true, true>(F.lds, g, S, E);
        } else {
            pg8::Gemm g{H, (const bf16*)(wl + W4_OFF), M, D, DFF}; pg8::StaticOrder S; S.init(M, D, F.G, F.bid);
            pg8::EpiResid E{F.out, F.ws, WS_SS2};
            if constexpr (PH_MASK & 64) pg8::gemm_phase<pg8::EpiResid, pg8::StaticOrder, true, true>(F.lds, g, S, E);
        }
      }
    }}

extern "C" void kernel_launch(void* const* d_in, const int* in_sizes, int n_in, void* d_out, int out_size, void* d_ws, size_t ws_size, hipStream_t stream) {
    static int grid = 0;
    if (grid == 0) {
        if (n_in != N_IN || out_size != (int)O_END || ws_size < WS_END) { fprintf(stderr, "kernel_launch: unexpected shapes (n_in %d out %d ws %zu)\n", n_in, out_size, ws_size); grid = -1; return; }
        int dev = 0, cus = 0;
        if (hipGetDevice(&dev) != hipSuccess || hipDeviceGetAttribute(&cus, hipDeviceAttributeMultiprocessorCount, dev) != hipSuccess) { grid = -1; return; }
        if (hipFuncSetAttribute((const void*)mk_fwd, hipFuncAttributeMaxDynamicSharedMemorySize, LDS_BYTES) != hipSuccess) { fprintf(stderr, "kernel_launch: hipFuncSetAttribute failed\n"); grid = -1; return; }
        int per_cu = 0;
        if (hipOccupancyMaxActiveBlocksPerMultiprocessor(&per_cu, (const void*)mk_fwd, NTHR, LDS_BYTES) != hipSuccess || per_cu < 1) fprintf(stderr, "kernel_launch: occupancy query says %d\n", per_cu);
        (void)hipGetLastError();
        grid = cus;
    }
    if (grid < 0) return;
    (void)hipMemsetAsync((char*)d_ws + WS_CTL, 0, CTL_ZERO_BYTES, stream);
    Args a{};
    for (int i = 0; i < N_IN; ++i) a.in[i] = (const float*)d_in[i];
    a.out = (float*)d_out; a.ws = (unsigned char*)d_ws;
#if MK_PER_PHASE
    for (int p = 0; p < MK_LAST; ++p) { if (!phase_exists(p) || ((MK_SKIP >> p) & 1ull)) continue; a.ph_lo = p; a.ph_hi = p + 1; a.use_bar = 0; hipLaunchKernelGGL(mk_fwd, dim3(grid), dim3(NTHR), LDS_BYTES, stream, a); }
#else
    a.ph_lo = 0; a.ph_hi = MK_LAST; a.use_bar = 1;
    hipLaunchKernelGGL(mk_fwd, dim3(grid), dim3(NTHR), LDS_BYTES, stream, a);
#endif
}
```
